# Optimizing an MI355X kernel written in HIP

```python
import math
import jax, jax.numpy as jnp
from jax import lax
import numpy as np

D_MODEL = 4096
BATCH = 4
SEQ = 2048
DEPTH = 2
DEC_BATCH = 32
DEC_SEQ = 1
PAST_LEN = 16384
PAGE_SIZE = 128

N_META = 16
N_MIXERS = 2
N_LAYERS_A = (DEPTH + 1) // 2
N_LAYERS_B = DEPTH // 2
HG_EXPAND = 128
HG_HEADS = D_MODEL // HG_EXPAND
HG_DK = HG_EXPAND
HG_DV = D_MODEL // HG_HEADS
HG_F = HG_HEADS * HG_DK
HG_CHUNK = 16
SW_HEADS = 64
SW_KV = 8
SW_HD = D_MODEL // SW_HEADS
SW_GROUP = SW_HEADS // SW_KV
WINDOW = 128
SW_BLOCK = 128
REL_BUCKETS = 32
REL_MAX_DIST = 128
EPS = 1e-6
NEG = -1e30

kernel_name = "hgrn2_swa_sink_hybrid_step"


def rms_norm(x, g):
    xf = x.astype(jnp.float32)
    y = xf * lax.rsqrt(jnp.mean(xf * xf, axis=-1, keepdims=True) + EPS)
    return (y * g.astype(jnp.float32)).astype(x.dtype)


def t5_bucket(dist):
    max_exact = REL_BUCKETS // 2
    d = jnp.maximum(dist, 1).astype(jnp.float32)
    large = max_exact + (jnp.log(d / max_exact) / math.log(REL_MAX_DIST / max_exact)
                         * (REL_BUCKETS - max_exact)).astype(jnp.int32)
    large = jnp.minimum(large, REL_BUCKETS - 1)
    return jnp.where(dist < max_exact, dist, large)


def rel_bias_heads(dist, table):
    b = table.astype(jnp.float32)[t5_bucket(jnp.maximum(dist, 0))]
    b = jnp.transpose(b, (2, 0, 1))
    return b.reshape(SW_KV, SW_GROUP, dist.shape[0], dist.shape[1])


def hgrn_project(h, w_in, lb):
    B, T, _ = h.shape
    proj = h @ w_in
    q = proj[..., :HG_F]
    fp = proj[..., HG_F:2 * HG_F].astype(jnp.float32)
    i = proj[..., 2 * HG_F:3 * HG_F]
    g = proj[..., 3 * HG_F:]
    q = jax.nn.silu(q.astype(jnp.float32)).reshape(B, T, HG_HEADS, HG_DK)
    f = lb + (1.0 - lb) * jax.nn.sigmoid(fp)
    logf = jnp.log(f).reshape(B, T, HG_HEADS, HG_DK)
    k = ((1.0 - lb) * jax.nn.sigmoid(-fp)).reshape(B, T, HG_HEADS, HG_DK)
    v = i.astype(jnp.float32).reshape(B, T, HG_HEADS, HG_DV)
    return q, k, v, logf, g


def hgrn_chunked(q, k, v, logf, S0):
    B, T, H, _ = q.shape
    N = T // HG_CHUNK
    def r(a):
        return a.reshape(B, N, HG_CHUNK, H, a.shape[-1]).transpose(1, 0, 3, 2, 4)
    causal = jnp.tril(jnp.ones((HG_CHUNK, HG_CHUNK), dtype=bool))
    def step(S, xs):
        qc, kc, vc, lc = xs
        b = jnp.cumsum(lc, axis=2)
        qt = qc * jnp.exp(b)
        kt = kc * jnp.exp(-b)
        A = jnp.where(causal, jnp.einsum('bhtk,bhsk->bhts', qt, kt), 0.0)
        o = jnp.einsum('bhtk,bhkv->bhtv', qt, S) + jnp.einsum('bhts,bhsv->bhtv', A, vc)
        bl = b[:, :, -1:, :]
        S = jnp.exp(bl[:, :, 0, :])[..., None] * S + jnp.einsum('bhsk,bhsv->bhkv', kc * jnp.exp(bl - b), vc)
        return S, o
    S, o = lax.scan(step, S0, (r(q), r(k), r(v), r(logf)))
    o = o.transpose(1, 0, 3, 2, 4).reshape(B, T, H, HG_DV)
    return o, S


def hgrn_recurrent(q, k, v, logf, S0):
    def step(S, xs):
        qt, kt, vt, lt = xs
        S = jnp.exp(lt)[..., None] * S + kt[..., None] * vt[..., None, :]
        return S, jnp.einsum('bhk,bhkv->bhv', qt, S)
    tr = lambda a: a.transpose(1, 0, 2, 3)
    S, o = lax.scan(step, S0, (tr(q), tr(k), tr(v), tr(logf)))
    return tr(o), S


def hgrn_out(o, g, onorm, w_out):
    B, T = o.shape[:2]
    o = o * lax.rsqrt(jnp.mean(o * o, axis=-1, keepdims=True) + EPS)
    o = o.reshape(B, T, D_MODEL) * onorm.astype(jnp.float32)
    return (o.astype(g.dtype) * jax.nn.silu(g)) @ w_out


def swa_project(h, w_in):
    B, T, _ = h.shape
    proj = h @ w_in
    nq, nk = SW_HEADS * SW_HD, SW_KV * SW_HD
    q = proj[..., :nq].reshape(B, T, SW_HEADS, SW_HD)
    k = proj[..., nq:nq + nk].reshape(B, T, SW_KV, SW_HD)
    v = proj[..., nq + nk:nq + 2 * nk].reshape(B, T, SW_KV, SW_HD)
    g = proj[..., nq + 2 * nk:]
    return q, k, v, g


def sink_softmax_av(s, sinks, v):
    sk = sinks.astype(jnp.float32).reshape(SW_KV, SW_GROUP, 1, 1)
    m = jnp.maximum(jnp.max(s, axis=-1, keepdims=True), sk)
    p = jnp.exp(s - m)
    den = jnp.sum(p, axis=-1, keepdims=True) + jnp.exp(sk - m)
    return jnp.einsum('bngqk,bnkd->bngqd', p / den, v.astype(jnp.float32))


def swa_prompt(q, k, v, sinks, table):
    B, T = q.shape[:2]
    pad = (-T) % SW_BLOCK
    Tp = T + pad
    nb = Tp // SW_BLOCK
    scale = SW_HD ** -0.5
    padf = lambda a: jnp.pad(a, ((0, 0), (pad, 0), (0, 0), (0, 0)))
    qb = padf(q).reshape(B, nb, SW_BLOCK, SW_KV, SW_GROUP, SW_HD).transpose(1, 0, 3, 4, 2, 5)
    def band(a):
        ab = padf(a).reshape(B, nb, SW_BLOCK, SW_KV, SW_HD)
        prev = jnp.concatenate([jnp.zeros_like(ab[:, :1]), ab[:, :-1]], axis=1)
        return jnp.concatenate([prev, ab], axis=2).transpose(1, 0, 3, 2, 4)
    kband, vband = band(k), band(v)
    key_pos = (jnp.arange(nb)[:, None] - 1) * SW_BLOCK + jnp.arange(2 * SW_BLOCK)[None, :]
    key_valid = key_pos >= pad
    dist = jnp.arange(SW_BLOCK)[:, None] + SW_BLOCK - jnp.arange(2 * SW_BLOCK)[None, :]
    in_win = (dist >= 0) & (dist <= WINDOW)
    bias = rel_bias_heads(dist, table)
    def block(xs):
        qk, kk, vk, kvv = xs
        s = jnp.einsum('bngqd,bnkd->bngqk', qk, kk).astype(jnp.float32) * scale + bias
        s = jnp.where(in_win & kvv[None, :], s, NEG)
        return sink_softmax_av(s, sinks, vk)
    o = lax.map(block, (qb, kband, vband, key_valid))
    o = o.transpose(1, 0, 4, 2, 3, 5).reshape(B, Tp, SW_HEADS, SW_HD)
    return o[:, pad:]


def swa_sample(q, k, v, ck, cv, sinks, table):
    B, T = q.shape[:2]
    R = ck.shape[1]
    kall = jnp.concatenate([ck.astype(k.dtype), k], axis=1)
    vall = jnp.concatenate([cv.astype(v.dtype), v], axis=1)
    qpos = PAST_LEN + jnp.arange(T)
    kpos = jnp.concatenate([PAST_LEN - R + jnp.arange(R), PAST_LEN + jnp.arange(T)])
    dist = qpos[:, None] - kpos[None, :]
    in_win = (dist >= 0) & (dist <= WINDOW)
    bias = rel_bias_heads(dist, table)
    qg = q.reshape(B, T, SW_KV, SW_GROUP, SW_HD)
    s = jnp.einsum('bqngd,bknd->bngqk', qg, kall).astype(jnp.float32) * (SW_HD ** -0.5) + bias
    s = jnp.where(in_win, s, NEG)
    o = sink_softmax_av(s, sinks, vall.transpose(0, 2, 1, 3))
    o = o.transpose(0, 3, 1, 2, 4).reshape(B, T, SW_HEADS, SW_HD)
    return o, kall[:, -R:], vall[:, -R:]


def swa_out(o, g, w_out):
    B, T = o.shape[:2]
    return (o.reshape(B, T, D_MODEL).astype(g.dtype) * jax.nn.silu(g)) @ w_out


def setup_inputs(seed: int = 0) -> dict:
    key = jax.random.key(seed)
    ks = jax.random.split(key, 18)
    nrm = lambda k, shp, s=1.0: jax.random.normal(k, shp, jnp.float32) * s
    win_rows = min(WINDOW, PAST_LEN)
    sw_in_cols = SW_HEADS * SW_HD + 2 * SW_KV * SW_HD + D_MODEL
    hg_in_cols = 3 * HG_F + D_MODEL
    return {
        "x_prompt": nrm(ks[0], (BATCH, SEQ, D_MODEL)),
        "x_sample": nrm(ks[1], (DEC_BATCH, DEC_SEQ, D_MODEL)),
        "state_hgrn": nrm(ks[2], (N_LAYERS_A, DEC_BATCH, HG_HEADS, HG_DK, HG_DV), 0.5),
        "cache_k_win": nrm(ks[3], (N_LAYERS_B, DEC_BATCH, win_rows, SW_KV, SW_HD)),
        "cache_v_win": nrm(ks[4], (N_LAYERS_B, DEC_BATCH, win_rows, SW_KV, SW_HD)),
        "meta_tokens": nrm(ks[5], (N_META, D_MODEL)),
        "rel_bias": nrm(ks[6], (REL_BUCKETS, SW_HEADS), 0.5),
        "hg_lower_bounds": nrm(ks[7], (DEPTH + 1, HG_F), 0.5),
        "hg_norm": 1.0 + nrm(ks[8], (N_LAYERS_A, D_MODEL), 0.02),
        "hg_w_in": nrm(ks[9], (N_LAYERS_A, D_MODEL, hg_in_cols), D_MODEL ** -0.5),
        "hg_onorm": 1.0 + nrm(ks[10], (N_LAYERS_A, D_MODEL), 0.02),
        "hg_w_out": nrm(ks[11], (N_LAYERS_A, D_MODEL, D_MODEL), D_MODEL ** -0.5),
        "sw_norm": 1.0 + nrm(ks[12], (N_LAYERS_B, D_MODEL), 0.02),
        "sw_w_in": nrm(ks[13], (N_LAYERS_B, D_MODEL, sw_in_cols), D_MODEL ** -0.5),
        "sw_sinks": nrm(ks[14], (N_LAYERS_B, SW_HEADS), 0.5),
        "sw_w_out": nrm(ks[15], (N_LAYERS_B, D_MODEL, D_MODEL), D_MODEL ** -0.5),
        "final_norm": 1.0 + nrm(ks[16], (D_MODEL,), 0.02),
    }


def reference(x_prompt, x_sample, state_hgrn, cache_k_win, cache_v_win, meta_tokens, rel_bias,
              hg_lower_bounds, hg_norm, hg_w_in, hg_onorm, hg_w_out,
              sw_norm, sw_w_in, sw_sinks, sw_w_out, final_norm):
    lb_all = jnp.cumsum(jax.nn.softmax(hg_lower_bounds.astype(jnp.float32), axis=0), axis=0)
    meta = jnp.broadcast_to(meta_tokens.astype(x_prompt.dtype)[None], (x_prompt.shape[0], N_META, D_MODEL))
    xp = jnp.concatenate([meta, x_prompt], axis=1)
    xs = x_sample
    hg_sp, hg_ss, kp_l, vp_l, ks_l, vs_l = [], [], [], [], [], []
    for i in range(DEPTH):
        if i % N_MIXERS == 0:
            a = i // N_MIXERS
            lb = lb_all[i]
            hp = rms_norm(xp, hg_norm[a])
            q, k, v, lf, g = hgrn_project(hp, hg_w_in[a], lb)
            S0 = jnp.zeros((xp.shape[0], HG_HEADS, HG_DK, HG_DV), jnp.float32)
            o, Sp = hgrn_chunked(q, k, v, lf, S0)
            xp = xp + hgrn_out(o, g, hg_onorm[a], hg_w_out[a])
            hs = rms_norm(xs, hg_norm[a])
            q, k, v, lf, g = hgrn_project(hs, hg_w_in[a], lb)
            o, Ss = hgrn_recurrent(q, k, v, lf, state_hgrn[a].astype(jnp.float32))
            xs = xs + hgrn_out(o, g, hg_onorm[a], hg_w_out[a])
            hg_sp.append(Sp.astype(state_hgrn.dtype))
            hg_ss.append(Ss.astype(state_hgrn.dtype))
        else:
            b = i // N_MIXERS
            hp = rms_norm(xp, sw_norm[b])
            q, k, v, g = swa_project(hp, sw_w_in[b])
            o = swa_prompt(q, k, v, sw_sinks[b], rel_bias)
            xp = xp + swa_out(o, g, sw_w_out[b])
            kp_l.append(k[:, -WINDOW:].astype(cache_k_win.dtype))
            vp_l.append(v[:, -WINDOW:].astype(cache_v_win.dtype))
            hs = rms_norm(xs, sw_norm[b])
            q, k, v, g = swa_project(hs, sw_w_in[b])
            o, nk, nv = swa_sample(q, k, v, cache_k_win[b], cache_v_win[b], sw_sinks[b], rel_bias)
            xs = xs + swa_out(o, g, sw_w_out[b])
            ks_l.append(nk.astype(cache_k_win.dtype))
            vs_l.append(nv.astype(cache_v_win.dtype))
    y_prompt = rms_norm(xp, final_norm)[:, N_META:]
    y_sample = rms_norm(xs, final_norm)
    return (y_prompt, y_sample, jnp.stack(hg_sp), jnp.stack(kp_l), jnp.stack(vp_l),
            jnp.stack(hg_ss), jnp.stack(ks_l), jnp.stack(vs_l))
```

```cpp
#include <hip/hip_runtime.h>
#include <hip/hip_cooperative_groups.h>
#include <cstdio>
#include <cstdint>
namespace cg = cooperative_groups;

#ifndef MK_N_LAUNCHES
#define MK_N_LAUNCHES 1
#endif

#ifndef PROBE_PHASE
#define PROBE_PHASE -1
#endif
#ifndef PGSP4
#define PGSP4 true
#endif
#ifndef PGSP2
#define PGSP2 true
#endif
#define LAS __attribute__((address_space(3)))
typedef unsigned short bf16_t;
typedef short bf16x8 __attribute__((ext_vector_type(8)));
typedef short s16x4 __attribute__((ext_vector_type(4)));
typedef float f32x2 __attribute__((ext_vector_type(2)));
typedef float f32x4 __attribute__((ext_vector_type(4)));
typedef float f32x16 __attribute__((ext_vector_type(16)));
typedef unsigned u32x2 __attribute__((ext_vector_type(2)));
typedef unsigned u32x4 __attribute__((ext_vector_type(4)));
typedef __bf16 bf16x2_t __attribute__((ext_vector_type(2)));

constexpr int D = 4096, BATCH = 4, SEQ = 2048, NMETA = 16, TP = SEQ + NMETA  , MPROMPT = BATCH * TP  , NS = 32, MV = MPROMPT + NS  , MP = 8448  ;
constexpr int N1 = 16384, N2 = 4096, N3 = 9216, N4 = 4096;
constexpr int LDK = 4096;
constexpr int MFULL = 8192;
constexpr int NCHUNK = TP / 16;
constexpr int WIN = 128;
constexpr float EPS = 1e-6f;

constexpr size_t KiB = 1024, MiB = 1u << 20;
constexpr size_t WS_CTL = 0, WS_SSQ1 = 64 * KiB, WS_SSQ2 = 136 * KiB, CTL_ZERO_BYTES = 256 * KiB;
constexpr size_t WS_RSTD0 = 256 * KiB, WS_LB = 320 * KiB, WS_BT = 336 * KiB;
constexpr size_t WS_EBL = 1 * MiB, WS_K3 = 10 * MiB, WS_V3 = 19 * MiB;
constexpr size_t WS_W1 = 28 * MiB, WS_W2 = 158 * MiB, WS_W3 = 191 * MiB, WS_W4 = 265 * MiB;
constexpr size_t WS_X1 = 298 * MiB, WS_B0 = 430 * MiB, BUFB = 68 * MiB, WS_SLAB = WS_B0 + 6 * BUFB  , WS_END = WS_SLAB + 32 * MiB;
constexpr size_t O_YP = 0, O_YS = 33554432, O_SP = O_YS + 131072, O_KP = O_SP + 2097152, O_VP = O_KP + 262144, O_SS = O_VP + 262144, O_KS = O_SS + 16777216, O_VS = O_KS + 2097152, O_END = O_VS + 2097152;

constexpr int LDS_BYTES = PGSP4 ? 163840 : 147456;
constexpr int MISC_OFF = 135168;

__device__ __forceinline__ int opaque_tid() { int t = threadIdx.x; asm volatile("" : "+v"(t)); return t; }
__device__ __forceinline__ unsigned pk2(float lo, float hi) { f32x2 v = {lo, hi}; bf16x2_t b = __builtin_convertvector(v, bf16x2_t); return __builtin_bit_cast(unsigned, b); }
__device__ __forceinline__ float bf_lo(unsigned w) { return __uint_as_float(w << 16); }
__device__ __forceinline__ float bf_hi(unsigned w) { return __uint_as_float(w & 0xffff0000u); }
__device__ __forceinline__ float bf1(bf16_t x) { return __uint_as_float(((unsigned)x) << 16); }
__device__ __forceinline__ float fexp(float x) { return __expf(x); }
__device__ __forceinline__ float frcp(float x) { return __builtin_amdgcn_rcpf(x); }
__device__ __forceinline__ float silu_f(float x) { return x * frcp(1.0f + fexp(-x)); }
template <int CTRL> __device__ __forceinline__ float dpp_f(float v) { return __int_as_float(__builtin_amdgcn_update_dpp(0, __float_as_int(v), CTRL, 0xf, 0xf, true)); }
__device__ __forceinline__ float row_scan16(float x) { x += dpp_f<0x111>(x); x += dpp_f<0x112>(x); x += dpp_f<0x114>(x); x += dpp_f<0x118>(x); return x; }
__device__ __forceinline__ float row_sum16(float x) { x += dpp_f<0x128>(x); x += dpp_f<0x124>(x); x += dpp_f<0x122>(x); x += dpp_f<0x121>(x); return x; }
__host__ __device__ __forceinline__ int perm32(int rho) { const int n = rho >> 4, i = rho & 15; return 8 * (i >> 2) + 4 * n + (i & 3); }
__device__ __forceinline__ const float* x0_row(const float* xp, const float* xs, const float* meta, int r) {
    if (r < MPROMPT) { const int b = r / TP, t = r - b * TP; return t < NMETA ? meta + (size_t)t * D : xp + ((size_t)b * SEQ + (t - NMETA)) * D; }
    if (r < MV) return xs + (size_t)(r - MPROMPT) * D;
    return nullptr;
}
__device__ __forceinline__ size_t hm_off(int r, int rb, int h) {
    if (rb < MPROMPT) { const int b = rb / TP; return ((size_t)(b * 32 + h) * TP + (r - b * TP)) * 128; }
    return ((size_t)BATCH * 32 * TP + (size_t)(r - MPROMPT) * 32 + h) * 128;
}
__device__ __forceinline__ float rstd_from_ssq(unsigned long long s) { return rsqrtf((float)((double)s * (1.0 / 4294967296.0)) * (1.0f / D) + EPS); }
__device__ __forceinline__ void ssq_add(unsigned long long* p, float ss) { atomicAdd(p, (unsigned long long)((double)ss * 4294967296.0)); }

namespace pg8 {
constexpr int BM = 256, BK = 64, HALF = 128, HTB = HALF * BK * 2, STAGE_BYTES = 8 * HTB, NXCD = 8, WGM = 8;
__host__ __device__ __forceinline__ int lds_byte(int r, int c) { const int st = (r >> 4) * 2 + (c >> 5), rr = r & 15, cc = c & 31, ob = rr * 64 + cc * 2; return st * 1024 + (ob ^ (((ob >> 9) & 1) << 5)); }
__host__ __device__ __forceinline__ void stage_rc(int b, int& R, int& C) { const int st = b / 1024, sb = b % 1024, swz = sb ^ (((sb >> 9) & 1) << 5); R = (st >> 1) * 16 + swz / 64; C = (st & 1) * 32 + (swz % 64) / 2; }
struct Unit { int pm, pn, k0, nk, part; };
struct Gemm { const bf16_t* A; const bf16_t* Bt; int M, N, K, ld; };
struct StaticOrder {
    int nM, nN, nwg, G, c;
    __host__ __device__ __forceinline__ void init(int M, int N, int G_, int c_) { nM = M / BM; nN = N / BM; nwg = nM * nN; G = G_; c = c_; }
    __host__ __device__ __forceinline__ bool tile(int i, int& pm, int& pn) const {
        const long L = (long)i * G + c; if (L >= nwg) { pm = 0; pn = 0; return false; }
        int wgid = (int)L; { const int q = nwg / NXCD, r = nwg % NXCD, xcd = wgid % NXCD, off = wgid / NXCD; wgid = (xcd < r ? xcd * (q + 1) : r * (q + 1) + (xcd - r) * q) + off; }
        const int nig = WGM * nN, gid = wgid / nig, fm = gid * WGM, gsz = (nM - fm) < WGM ? (nM - fm) : WGM;
        pm = fm + ((wgid % nig) % gsz); pn = (wgid % nig) / gsz; return true;
    }
    __host__ __device__ __forceinline__ bool next(int i, Unit& u) const { int pm, pn; const bool ok = tile(i, pm, pn); u.pm = pm; u.pn = pn; u.k0 = 0; u.nk = 64; u.part = -1; return ok; }
};
template <int KS, int COFF, int GS> struct TailOrder {
    StaticOrder so; int nfull, NT, pmt;
    __host__ __device__ __forceinline__ void init(int Mfull, int N, int G_, int c_) { so.init(Mfull, N, G_, c_); nfull = c_ < so.nwg ? (so.nwg - c_ + G_ - 1) / G_ : 0; NT = so.nN * KS; pmt = Mfull / BM; }
    __host__ __device__ __forceinline__ bool next(int i, Unit& u) const {
        int pm, pn, k0 = 0, nk = 64, part = -1; bool ok;
        if (i < nfull) ok = so.tile(i, pm, pn);
        else {
            const int gs = GS ? GS : so.G; int tc = so.c - COFF; if (tc < 0) tc += so.G;
            const int s = tc + (i - nfull) * gs; ok = (tc < gs) && (s < NT);
            pm = pmt; pn = s / KS; nk = 64 / KS; k0 = (s - pn * KS) * nk; part = s;
        }
        u.pm = pm; u.pn = pn; u.k0 = k0; u.nk = nk; u.part = part; return ok;
    }
};
template <class Epi, class Sched, bool ALIGN_EPI, bool SP2, class Bar, int ABLATE = 0>
__device__ __forceinline__ void gemm_phase(LAS unsigned char* lds, const Gemm g, const Sched& S, const Epi& E, float* slab, const Bar ubar, bool usync, int urounds) {
    const int tid = opaque_tid(), wid = __builtin_amdgcn_readfirstlane(tid >> 6), lane = tid & 63, wr = wid >> 2, wc = wid & 3, fr = lane & 15, fq = lane >> 4;
    constexpr int ld = LDK;
    unsigned voff[2];
#pragma unroll
    for (int i = 0; i < 2; ++i) { int R, C; stage_rc(tid * 16 + i * 8192, R, C); voff[i] = (unsigned)(R * ld + C) * 2u; }
    const unsigned kstep = (unsigned)(BK * 2), hstep = (unsigned)(HALF * ld * 2), tstep = 2u * hstep;
    const __amdgpu_buffer_rsrc_t rA = __builtin_amdgcn_make_buffer_rsrc((void*)g.A, 0, ABLATE == 5 ? 0 : (int)((unsigned)g.M * (unsigned)ld * 2u), 0x00020000);
    const __amdgpu_buffer_rsrc_t rB = __builtin_amdgcn_make_buffer_rsrc((void*)g.Bt, 0, ABLATE == 5 ? 0 : (int)((unsigned)g.N * (unsigned)ld * 2u), 0x00020000);
    const unsigned ldsm0 = __builtin_amdgcn_readfirstlane((unsigned)(size_t)lds + (unsigned)wid * 1024u);
    const int aoff = lds_byte(wr * 64 + fr, fq * 8), boff = lds_byte(wc * 32 + fr, fq * 8);
#define PG8_SA(b, h) (((b) * 2 + (h)) * HTB)
#define PG8_SB(b, h) ((4 + (b) * 2 + (h)) * HTB)
#define PG8_STAGE(bufoff, rs, so) do { if (ABLATE == 3) break; _Pragma("unroll") for (int _i = 0; _i < 2; ++_i) \
        asm volatile("s_add_u32 m0, %0, %4\n\ts_nop 0\n\tbuffer_load_dwordx4 %1, %2, %3 offen lds" :: "s"(ldsm0), "v"(voff[_i]), "s"(rs), "s"(so), "n"((bufoff) + _i * 8192) : "m0", "scc", "memory"); } while (0)
#define PG8_LDA(dst, b, h) do { if (ABLATE == 2) break; _Pragma("unroll") for (int m = 0; m < 4; ++m) _Pragma("unroll") for (int k = 0; k < 2; ++k) dst[m][k] = *(const LAS bf16x8*)(lds + PG8_SA(b, h) + aoff + m * 2048 + k * 1024); } while (0)
#define PG8_LDB(dst, b, h) do { if (ABLATE == 2) break; _Pragma("unroll") for (int n = 0; n < 2; ++n) _Pragma("unroll") for (int k = 0; k < 2; ++k) dst[n][k] = *(const LAS bf16x8*)(lds + PG8_SB(b, h) + boff + n * 2048 + k * 1024); } while (0)
#define PG8_MMA(ai, bj, At, Bt) do { if (ABLATE == 1 && (ai) == 1) break; if (ABLATE == 4) break; __builtin_amdgcn_s_setprio(1); _Pragma("unroll") for (int m = 0; m < 4; ++m) _Pragma("unroll") for (int n = 0; n < 2; ++n) _Pragma("unroll") for (int k = 0; k < 2; ++k) \
        acc[ai][bj][m][n] = __builtin_amdgcn_mfma_f32_16x16x32_bf16(Bt[n][k], At[m][k], acc[ai][bj][m][n], 0, 0, 0); __builtin_amdgcn_s_setprio(0); } while (0)
#define PG8_WAIT_V(n) asm volatile("s_waitcnt vmcnt(" #n ")" ::: "memory")
#define PG8_WAIT_L(n) asm volatile("s_waitcnt lgkmcnt(" #n ")" ::: "memory")
#define PG8_BAR __builtin_amdgcn_s_barrier()
#define PG8_SCHED __builtin_amdgcn_sched_barrier(0)
    Unit cur, nxt; int ui = 0;
    if (!S.next(0, cur)) { if (usync) for (int r_ = 0; r_ < urounds; ++r_) ubar.sync(); return; }
    f32x4 acc[2][2][4][2];
#pragma unroll
    for (int a = 0; a < 2; ++a)
#pragma unroll
        for (int b = 0; b < 2; ++b)
#pragma unroll
            for (int m = 0; m < 4; ++m)
#pragma unroll
                for (int n = 0; n < 2; ++n) acc[a][b][m][n] = (f32x4){0.f, 0.f, 0.f, 0.f};
    bf16x8 At[4][2], B0[2][2], B1[2][2];
    unsigned cA = (unsigned)cur.pm * tstep + (unsigned)cur.k0 * kstep, cB = (unsigned)cur.pn * tstep + (unsigned)cur.k0 * kstep;
    if constexpr (PGSP4) {
    bf16x8 At1[4][2];
    const int oth = 1 - wr;
    const unsigned ldsm0A = __builtin_amdgcn_readfirstlane((unsigned)(size_t)lds + (unsigned)oth * 8192u + (unsigned)(wid & 3) * 2048u);
    unsigned vl; { int R, C; stage_rc(lane * 16, R, C); vl = (unsigned)(R * ld + C) * 2u; }
    const unsigned cwA = (unsigned)((oth * 4 + (wid & 3)) * 16) * (unsigned)(ld * 2), cwB = (unsigned)((wid >> 1) * 16) * (unsigned)(ld * 2) + (unsigned)(wid & 1) * 64u;
    cA += cwA; cB += cwB;
#define PG8_DMA2(m0base, imm, vo, rs, so, soimm) do { unsigned _t; asm volatile("s_add_u32 m0, %1, %5\n\ts_add_u32 %0, %4, %6\n\tbuffer_load_dwordx4 %2, %3, %0 offen lds" : "=&s"(_t) : "s"(m0base), "v"(vo), "s"(rs), "s"(so), "n"(imm), "n"(soimm) : "m0", "scc", "memory"); } while (0)
#define PG8_DAP(ma, h, i, pa) do { if (ABLATE != 3) PG8_DMA2(ma, (h) * HTB + (i) * 1024, vl, rA, (pa), (h) * (HALF * LDK * 2) + (i) * 64); } while (0)
#define PG8_DBR(mb, h, i, pb) do { if (ABLATE != 3) PG8_DMA2(mb, (h) * HTB + (i) * 8192, vl, rB, (pb), (h) * (HALF * LDK * 2) + (i) * (64 * LDK * 2)); } while (0)
#define PG8_STAGE_AP(abuf, pa) do { const unsigned _m = ldsm0A + (abuf), _p = (pa); PG8_DAP(_m, 0, 0, _p); PG8_DAP(_m, 0, 1, _p); PG8_DAP(_m, 1, 0, _p); PG8_DAP(_m, 1, 1, _p); } while (0)
#define PG8_STAGE_BR(slot, pb) do { const unsigned _m = ldsm0 + (slot), _p = (pb); PG8_DBR(_m, 0, 0, _p); PG8_DBR(_m, 0, 1, _p); PG8_DBR(_m, 1, 0, _p); PG8_DBR(_m, 1, 1, _p); } while (0)
#define PG8_LDBR(dst, bb, h) do { if (ABLATE == 2) break; _Pragma("unroll") for (int n = 0; n < 2; ++n) _Pragma("unroll") for (int k = 0; k < 2; ++k) dst[n][k] = *(const LAS bf16x8*)((bb) + (h) * HTB + n * 2048 + k * 1024); } while (0)
#define PG8_LOAD4(b, slot) do { const LAS unsigned char* _bb = lds + (slot) + boff; PG8_LDBR(B0, _bb, 0); PG8_LDBR(B1, _bb, 1); PG8_LDA(At, b, 0); PG8_LDA(At1, b, 1); } while (0)
#define PG8_PINB() asm volatile("" : "+v"(B0[0][0]), "+v"(B0[0][1]), "+v"(B0[1][0]), "+v"(B0[1][1]), "+v"(B1[0][0]), "+v"(B1[0][1]), "+v"(B1[1][0]), "+v"(B1[1][1]))
#define PG8_PINC1(a, b) asm volatile("" : "+v"(acc[a][b][0][0]), "+v"(acc[a][b][0][1]), "+v"(acc[a][b][1][0]), "+v"(acc[a][b][1][1]), "+v"(acc[a][b][2][0]), "+v"(acc[a][b][2][1]), "+v"(acc[a][b][3][0]), "+v"(acc[a][b][3][1]))
#define PG8_PINC() do { PG8_PINC1(0, 0); PG8_PINC1(0, 1); PG8_PINC1(1, 0); PG8_PINC1(1, 1); } while (0)
#define PG8_MMA4() do { PG8_PINB(); PG8_MMA(0, 0, At, B0); PG8_MMA(0, 1, At, B1); PG8_MMA(1, 0, At1, B0); PG8_MMA(1, 1, At1, B1); PG8_PINC(); } while (0)
    unsigned r0 = 4u * HTB, r1 = 6u * HTB, r2 = 8u * HTB;
    PG8_STAGE_AP(PG8_SA(0, 0), cA); if (wr == 1) PG8_STAGE_AP(PG8_SA(1, 0), cA + kstep); PG8_STAGE_BR(r0, cB); PG8_STAGE_BR(r1, cB + kstep);
    PG8_WAIT_V(0);
    PG8_BAR;
    if (wr == 1) PG8_BAR;
    for (;;) {
        const bool has_next = S.next(ui + 1, nxt);
        const unsigned nA = has_next ? (unsigned)nxt.pm * tstep + (unsigned)nxt.k0 * kstep + cwA : cA, nB = has_next ? (unsigned)nxt.pn * tstep + (unsigned)nxt.k0 * kstep + cwB : cB;
        int nt = cur.nk; asm volatile("" : "+s"(nt));
        __builtin_amdgcn_s_waitcnt(0x0F70);
        for (int t = 0; t < nt; t += 2) {
            const unsigned dA = (t + 2 < nt) ? cA + (unsigned)(t + 2) * kstep : nA + (unsigned)(t + 2 - nt) * kstep;
            const unsigned dB = (t + 2 < nt) ? cB + (unsigned)(t + 2) * kstep : nB + (unsigned)(t + 2 - nt) * kstep;
            PG8_LOAD4(0, r0);
            { const unsigned ab = wr ? (unsigned)PG8_SA(0, 0) : (unsigned)PG8_SA(1, 0), pa = wr ? dA : cA + (unsigned)(t + 1) * kstep; PG8_STAGE_AP(ab, pa); PG8_STAGE_BR(r2, dB); }
            PG8_WAIT_L(0); PG8_WAIT_V(8); PG8_BAR;
            PG8_MMA4(); PG8_BAR; PG8_SCHED;
            PG8_LOAD4(1, r1);
            { const unsigned ab = wr ? (unsigned)PG8_SA(1, 0) : (unsigned)PG8_SA(0, 0), pa = wr ? dA + kstep : dA; PG8_STAGE_AP(ab, pa); PG8_STAGE_BR(r0, dB + kstep); }
            PG8_WAIT_L(0); PG8_WAIT_V(8); PG8_BAR;
            PG8_MMA4(); PG8_BAR; PG8_SCHED;
            { const unsigned q = r0; r0 = r2; r2 = r1; r1 = q; }
        }
        if constexpr (ALIGN_EPI) { if (wr == 0) PG8_BAR; }
        const int tid2 = opaque_tid(), lane2 = tid2 & 63, wid2 = __builtin_amdgcn_readfirstlane(tid2 >> 6), wr2 = wid2 >> 2, wc2 = wid2 & 3, fr2 = lane2 & 15, fq2 = lane2 >> 4;
        if (cur.part >= 0) {
            float* sp = slab + ((size_t)cur.part * 16 * 512 + tid2) * 4;
#pragma unroll
            for (int bj = 0; bj < 2; ++bj)
#pragma unroll
                for (int m = 0; m < 4; ++m)
#pragma unroll
                    for (int n = 0; n < 2; ++n) *(f32x4*)(sp + (size_t)((bj * 4 + m) * 2 + n) * 512 * 4) = acc[0][bj][m][n];
        } else {
#pragma unroll
            for (int ai = 0; ai < 2; ++ai) {
                typename Epi::Pre pr[4];
#pragma unroll
                for (int m = 0; m < 4; ++m) pr[m] = E.pre(cur, ai, m, wr2, wc2, fr2, fq2);
#pragma unroll
                for (int m = 0; m < 4; ++m) { const f32x4 a4[2][2] = {{acc[ai][0][m][0], acc[ai][0][m][1]}, {acc[ai][1][m][0], acc[ai][1][m][1]}}; E.rows(a4, pr[m], cur, ai, m, wr2, wc2, fr2, fq2); }
            }
        }
        if (usync) ubar.sync();
        if (!has_next) break;
#pragma unroll
        for (int a = 0; a < 2; ++a)
#pragma unroll
            for (int b = 0; b < 2; ++b)
#pragma unroll
                for (int m = 0; m < 4; ++m)
#pragma unroll
                    for (int n = 0; n < 2; ++n) acc[a][b][m][n] = (f32x4){0.f, 0.f, 0.f, 0.f};
        cur = nxt; cA = nA; cB = nB; ++ui;
        if constexpr (ALIGN_EPI) { if (wr == 1) PG8_BAR; }
    }
    PG8_WAIT_V(0);
    if constexpr (!ALIGN_EPI) { if (wr == 0) PG8_BAR; }
    PG8_BAR;
    if (usync) for (int r_ = ui + 1; r_ < urounds; ++r_) ubar.sync();
#undef PG8_DMA2
#undef PG8_STAGE_AP
#undef PG8_STAGE_BR
#undef PG8_LDBR
#undef PG8_LOAD4
#undef PG8_MMA4
#undef PG8_PINB
#undef PG8_PINC1
#undef PG8_PINC
#undef PG8_DAP
#undef PG8_DBR
    } else {
    if constexpr (SP2) {
        PG8_STAGE(PG8_SB(0, 0), rB, cB); PG8_STAGE(PG8_SB(0, 1), rB, cB + hstep); PG8_STAGE(PG8_SA(0, 0), rA, cA); PG8_STAGE(PG8_SA(0, 1), rA, cA + hstep);
        if (wr == 1) PG8_BAR;
        PG8_WAIT_V(2); PG8_BAR;
        PG8_STAGE(PG8_SB(1, 0), rB, cB + kstep); PG8_STAGE(PG8_SA(1, 0), rA, cA + kstep); PG8_STAGE(PG8_SB(1, 1), rB, cB + hstep + kstep);
        PG8_WAIT_V(6); PG8_BAR;
    } else {
        PG8_STAGE(PG8_SB(0, 0), rB, cB); PG8_STAGE(PG8_SA(0, 0), rA, cA); PG8_STAGE(PG8_SB(0, 1), rB, cB + hstep); PG8_STAGE(PG8_SA(0, 1), rA, cA + hstep);
        if (wr == 1) PG8_BAR;
        PG8_WAIT_V(4); PG8_BAR;
        PG8_STAGE(PG8_SB(1, 0), rB, cB + kstep); PG8_STAGE(PG8_SA(1, 0), rA, cA + kstep); PG8_STAGE(PG8_SB(1, 1), rB, cB + hstep + kstep);
        PG8_WAIT_V(6); PG8_BAR;
    }
    for (;;) {
        const bool has_next = S.next(ui + 1, nxt);
        const unsigned nA = has_next ? (unsigned)nxt.pm * tstep + (unsigned)nxt.k0 * kstep : cA, nB = has_next ? (unsigned)nxt.pn * tstep + (unsigned)nxt.k0 * kstep : cB;
        const int nt = cur.nk;
        for (int t = 0; t < nt; t += 2) {
            const bool last = (t == nt - 2);
            const unsigned a1 = cA + (unsigned)(t + 1) * kstep;
            const unsigned a2 = last ? nA : cA + (unsigned)(t + 2) * kstep, b2 = last ? nB : cB + (unsigned)(t + 2) * kstep;
            const unsigned a3 = a2 + kstep, b3 = b2 + kstep;
            if constexpr (SP2) {
            PG8_LDB(B0, 0, 0); PG8_LDB(B1, 0, 1); PG8_SCHED; PG8_LDA(At, 0, 0); PG8_STAGE(PG8_SA(1, 1), rA, a1 + hstep);
            PG8_WAIT_V(8); PG8_WAIT_L(0); PG8_BAR; PG8_MMA(0, 0, At, B0); PG8_MMA(0, 1, At, B1); PG8_BAR; PG8_SCHED;
            PG8_LDA(At, 0, 1); PG8_STAGE(PG8_SB(0, 0), rB, b2); PG8_STAGE(PG8_SB(0, 1), rB, b2 + hstep); PG8_STAGE(PG8_SA(0, 0), rA, a2);
            PG8_WAIT_V(8); PG8_WAIT_L(0); PG8_BAR; PG8_MMA(1, 0, At, B0); PG8_MMA(1, 1, At, B1); PG8_BAR; PG8_SCHED;
            PG8_LDB(B0, 1, 0); PG8_LDB(B1, 1, 1); PG8_SCHED; PG8_LDA(At, 1, 0); PG8_STAGE(PG8_SA(0, 1), rA, a2 + hstep);
            PG8_WAIT_V(8); PG8_WAIT_L(0); PG8_BAR; PG8_MMA(0, 0, At, B0); PG8_MMA(0, 1, At, B1); PG8_BAR; PG8_SCHED;
            PG8_LDA(At, 1, 1); PG8_STAGE(PG8_SB(1, 0), rB, b3); PG8_STAGE(PG8_SB(1, 1), rB, b3 + hstep); PG8_STAGE(PG8_SA(1, 0), rA, a3);
            PG8_WAIT_V(8); PG8_WAIT_L(0); PG8_BAR; PG8_MMA(1, 0, At, B0); PG8_MMA(1, 1, At, B1); PG8_BAR; PG8_SCHED;
            } else {
            PG8_LDB(B0, 0, 0); PG8_SCHED; PG8_LDA(At, 0, 0); PG8_STAGE(PG8_SA(1, 1), rA, a1 + hstep);
            PG8_WAIT_L(8); PG8_BAR; PG8_WAIT_L(0); PG8_MMA(0, 0, At, B0); PG8_BAR; PG8_SCHED;
            PG8_LDB(B1, 0, 1); PG8_STAGE(PG8_SB(0, 0), rB, b2);
            PG8_BAR; PG8_WAIT_L(0); PG8_MMA(0, 1, At, B1); PG8_BAR;
            PG8_LDA(At, 0, 1); PG8_STAGE(PG8_SA(0, 0), rA, a2);
            PG8_BAR; PG8_WAIT_L(0); PG8_MMA(1, 0, At, B0); PG8_BAR; PG8_SCHED;
            PG8_STAGE(PG8_SB(0, 1), rB, b2 + hstep);
            PG8_WAIT_V(6); PG8_BAR; PG8_MMA(1, 1, At, B1); PG8_BAR;
            PG8_LDB(B0, 1, 0); PG8_SCHED; PG8_LDA(At, 1, 0); PG8_STAGE(PG8_SA(0, 1), rA, a2 + hstep);
            PG8_WAIT_L(8); PG8_BAR; PG8_WAIT_L(0); PG8_MMA(0, 0, At, B0); PG8_BAR; PG8_SCHED;
            PG8_LDB(B1, 1, 1); PG8_STAGE(PG8_SB(1, 0), rB, b3);
            PG8_BAR; PG8_WAIT_L(0); PG8_MMA(0, 1, At, B1); PG8_BAR;
            PG8_LDA(At, 1, 1); PG8_STAGE(PG8_SA(1, 0), rA, a3);
            PG8_BAR; PG8_WAIT_L(0); PG8_MMA(1, 0, At, B0); PG8_BAR; PG8_SCHED;
            PG8_STAGE(PG8_SB(1, 1), rB, b3 + hstep);
            PG8_WAIT_V(6); PG8_BAR; PG8_MMA(1, 1, At, B1); PG8_BAR;
            }
        }
        if constexpr (ALIGN_EPI) { if (wr == 0) PG8_BAR; }
        const int tid2 = opaque_tid(), lane2 = tid2 & 63, wid2 = __builtin_amdgcn_readfirstlane(tid2 >> 6), wr2 = wid2 >> 2, wc2 = wid2 & 3, fr2 = lane2 & 15, fq2 = lane2 >> 4;
        if (cur.part >= 0) {
            float* sp = slab + ((size_t)cur.part * 16 * 512 + tid2) * 4;
#pragma unroll
            for (int bj = 0; bj < 2; ++bj)
#pragma unroll
                for (int m = 0; m < 4; ++m)
#pragma unroll
                    for (int n = 0; n < 2; ++n) *(f32x4*)(sp + (size_t)((bj * 4 + m) * 2 + n) * 512 * 4) = acc[0][bj][m][n];
        } else {
#pragma unroll
            for (int ai = 0; ai < 2; ++ai) {
                typename Epi::Pre pr[4];
#pragma unroll
                for (int m = 0; m < 4; ++m) pr[m] = E.pre(cur, ai, m, wr2, wc2, fr2, fq2);
#pragma unroll
                for (int m = 0; m < 4; ++m) { const f32x4 a4[2][2] = {{acc[ai][0][m][0], acc[ai][0][m][1]}, {acc[ai][1][m][0], acc[ai][1][m][1]}}; E.rows(a4, pr[m], cur, ai, m, wr2, wc2, fr2, fq2); }
            }
        }
        if (usync) ubar.sync();
        if (!has_next) break;
#pragma unroll
        for (int a = 0; a < 2; ++a)
#pragma unroll
            for (int b = 0; b < 2; ++b)
#pragma unroll
                for (int m = 0; m < 4; ++m)
#pragma unroll
                    for (int n = 0; n < 2; ++n) acc[a][b][m][n] = (f32x4){0.f, 0.f, 0.f, 0.f};
        cur = nxt; cA = nA; cB = nB; ++ui;
        if constexpr (ALIGN_EPI) { if (wr == 1) PG8_BAR; }
    }
    PG8_WAIT_V(0);
    if constexpr (!ALIGN_EPI) { if (wr == 0) PG8_BAR; }
    PG8_BAR;
    if (usync) for (int r_ = ui + 1; r_ < urounds; ++r_) ubar.sync();
    }
#undef PG8_SA
#undef PG8_SB
#undef PG8_STAGE
#undef PG8_LDA
#undef PG8_LDB
#undef PG8_MMA
#undef PG8_WAIT_V
#undef PG8_WAIT_L
#undef PG8_BAR
#undef PG8_SCHED
}
template <int KS, class Epi> __device__ __forceinline__ void gemm_tail_fixup(const float* slab, int nN, int pmt, int G, int c, const Epi& E) {
    const int tid = opaque_tid(), wid = __builtin_amdgcn_readfirstlane(tid >> 6), lane = tid & 63, wr = wid >> 2, wc = wid & 3, fr = lane & 15, fq = lane >> 4;
    for (int pc = c; pc < nN * 4; pc += G) {
        const int pn = pc >> 2, m = pc & 3;
        f32x4 t[2][2];
#pragma unroll
        for (int bj = 0; bj < 2; ++bj)
#pragma unroll
            for (int n = 0; n < 2; ++n) t[bj][n] = (f32x4){0.f, 0.f, 0.f, 0.f};
#pragma unroll 4
        for (int ks = 0; ks < KS; ++ks) {
            const float* sp = slab + ((size_t)(pn * KS + ks) * 16 * 512 + tid) * 4;
#pragma unroll
            for (int bj = 0; bj < 2; ++bj)
#pragma unroll
                for (int n = 0; n < 2; ++n) t[bj][n] += *(const f32x4*)(sp + (size_t)((bj * 4 + m) * 2 + n) * 512 * 4);
        }
        Unit u; u.pm = pmt; u.pn = pn; u.k0 = 0; u.nk = 64; u.part = -1;
        E.rows(t, E.pre(u, 0, m, wr, wc, fr, fq), u, 0, m, wr, wc, fr, fq);
    }
}
}

typedef const f32x4 (&Acc4)[2][2];
__device__ __forceinline__ u32x4 pack8(const f32x4& a, const f32x4& b) { u32x4 w; w.x = pk2(a[0], a[1]); w.y = pk2(a[2], a[3]); w.z = pk2(b[0], b[1]); w.w = pk2(b[2], b[3]); return w; }

struct EpiHg {
    bf16_t *QT, *KT, *KD, *V, *SG; float* EBL; const float* RSTD0; const float* LB;
    struct Pre { float rs; };
    __device__ __forceinline__ Pre pre(const pg8::Unit& u, int ai, int m, int wr, int wc, int fr, int fq) const { Pre p; p.rs = RSTD0[u.pm * 256 + ai * 128 + wr * 64 + m * 16 + fr]; return p; }
    __device__ __forceinline__ void rows(Acc4 a, const Pre& pr, const pg8::Unit& u, int ai, int m, int wr, int wc, int fr, int fq) const {
        const int pn = u.pn, r = u.pm * 256 + ai * 128 + wr * 64 + m * 16 + fr; const float rs = pr.rs;
        if (pn < 32) {
            const int col = pn * 128 + wc * 32 + 8 * fq;
            const f32x4 l0 = *(const f32x4*)(LB + col), l1 = *(const f32x4*)(LB + col + 4);
            const float lbv[8] = {l0[0], l0[1], l0[2], l0[3], l1[0], l1[1], l1[2], l1[3]};
            const bool prompt = (r - fr) < MPROMPT;
            float qo[8], ko[8], eb8[8], lg[8];
#pragma unroll
            for (int n = 0; n < 2; ++n)
#pragma unroll
                for (int j = 0; j < 4; ++j) {
                    const int ix = 4 * n + j;
                    const float q = a[0][n][j] * rs; float f = a[1][n][j] * rs;
                    f = fminf(fmaxf(f, -60.f), 60.f);
                    const float e = fexp(-f), sig = frcp(1.0f + e), oms = e * sig, oml = 1.0f - lbv[ix];
                    const float fg = lbv[ix] + oml * sig;
                    qo[ix] = silu_f(q); ko[ix] = oml * oms; lg[ix] = fg; eb8[ix] = 0.f;
                }
            if (prompt) {
#pragma unroll
                for (int ix = 0; ix < 8; ++ix) lg[ix] = __builtin_amdgcn_logf(lg[ix]);
#pragma unroll
                for (int ix = 0; ix < 8; ++ix) lg[ix] += dpp_f<0x111>(lg[ix]);
#pragma unroll
                for (int ix = 0; ix < 8; ++ix) lg[ix] += dpp_f<0x112>(lg[ix]);
#pragma unroll
                for (int ix = 0; ix < 8; ++ix) lg[ix] += dpp_f<0x114>(lg[ix]);
#pragma unroll
                for (int ix = 0; ix < 8; ++ix) lg[ix] += dpp_f<0x118>(lg[ix]);
#pragma unroll
                for (int ix = 0; ix < 8; ++ix) { const float ebc = __builtin_amdgcn_exp2f(lg[ix]), ieb = __builtin_amdgcn_exp2f(-lg[ix]);
                    qo[ix] *= ebc; ko[ix] *= ieb; eb8[ix] = ebc; }
            }
            const size_t o = hm_off(r, r - fr, pn) + wc * 32 + 8 * fq;
            u32x4 w; w.x = pk2(qo[0], qo[1]); w.y = pk2(qo[2], qo[3]); w.z = pk2(qo[4], qo[5]); w.w = pk2(qo[6], qo[7]); __builtin_nontemporal_store(w, (u32x4*)(QT + o));
            w.x = pk2(ko[0], ko[1]); w.y = pk2(ko[2], ko[3]); w.z = pk2(ko[4], ko[5]); w.w = pk2(ko[6], ko[7]); __builtin_nontemporal_store(w, (u32x4*)(KT + o));
            if (prompt && fr == 15) { const int b = r / TP; float* ep = EBL + ((size_t)(b * 32 + pn) * NCHUNK + ((r - b * TP) >> 4)) * 128 + wc * 32 + 8 * fq; *(f32x4*)ep = (f32x4){eb8[0], eb8[1], eb8[2], eb8[3]}; *(f32x4*)(ep + 4) = (f32x4){eb8[4], eb8[5], eb8[6], eb8[7]}; }
        } else {
            const bool isg = pn >= 48; bf16_t* dst = isg ? SG : V;
            const int h0 = (pn - (isg ? 48 : 32)) * 2;
#pragma unroll
            for (int bj = 0; bj < 2; ++bj) {
                f32x4 v0 = a[bj][0] * rs, v1 = a[bj][1] * rs;
                if (isg) {
#pragma unroll
                    for (int j = 0; j < 4; ++j) { v0[j] = silu_f(v0[j]); v1[j] = silu_f(v1[j]); } }
                __builtin_nontemporal_store(pack8(v0, v1), (u32x4*)(dst + hm_off(r, r - fr, h0 + bj) + wc * 32 + 8 * fq));
            }
        }
    }
};
struct EpiRes {
    const bf16_t* XI; bf16_t* XO; unsigned long long* SSQ;
    struct Pre { u32x4 x[2]; };
    __device__ __forceinline__ Pre pre(const pg8::Unit& u, int ai, int m, int wr, int wc, int fr, int fq) const {
        const int col0 = u.pn * 256 + wc * 32 + 8 * fq, r = u.pm * 256 + ai * 128 + wr * 64 + m * 16 + fr; Pre p;
#pragma unroll
        for (int bj = 0; bj < 2; ++bj) p.x[bj] = *(const u32x4*)(XI + (size_t)r * LDK + col0 + bj * 128);
        return p; }
    __device__ __forceinline__ void rows(Acc4 a, const Pre& pr, const pg8::Unit& u, int ai, int m, int wr, int wc, int fr, int fq) const {
        const int col0 = u.pn * 256 + wc * 32 + 8 * fq, r = u.pm * 256 + ai * 128 + wr * 64 + m * 16 + fr;
        float ss = 0.f;
#pragma unroll
        for (int bj = 0; bj < 2; ++bj) {
            const size_t o = (size_t)r * LDK + col0 + bj * 128;
            const u32x4 xw = pr.x[bj];
            const f32x4 a0 = {bf_lo(xw.x), bf_hi(xw.x), bf_lo(xw.y), bf_hi(xw.y)}, a1 = {bf_lo(xw.z), bf_hi(xw.z), bf_lo(xw.w), bf_hi(xw.w)};
            const f32x4 v0 = a[bj][0] + a0, v1 = a[bj][1] + a1;
            *(u32x4*)(XO + o) = pack8(v0, v1);
            ss += (v0[0] * v0[0] + v0[1] * v0[1]) + (v0[2] * v0[2] + v0[3] * v0[3]) + (v1[0] * v1[0] + v1[1] * v1[1]) + (v1[2] * v1[2] + v1[3] * v1[3]);
        }
        ss += __shfl_xor(ss, 16); ss += __shfl_xor(ss, 32);
        if (fq == 0) ssq_add(SSQ + r, ss);
    }
};
struct EpiSw {
    bf16_t *Q3, *K3, *V3, *SG3; const unsigned long long* SSQ;
    struct Pre { unsigned long long s; };
    __device__ __forceinline__ Pre pre(const pg8::Unit& u, int ai, int m, int wr, int wc, int fr, int fq) const { Pre p; p.s = SSQ[u.pm * 256 + ai * 128 + wr * 64 + m * 16 + fr]; return p; }
    __device__ __forceinline__ void rows(Acc4 a, const Pre& pr, const pg8::Unit& u, int ai, int m, int wr, int wc, int fr, int fq) const {
        const int pn = u.pn; bf16_t* dst; int ld, colt; float sc = 1.f; bool act = false;
        if (pn < 16) { dst = Q3; ld = D; colt = pn * 256; sc = 0.125f * 1.4426950408889634f; }
        else if (pn < 18) { dst = K3; ld = 512; colt = (pn - 16) * 256; }
        else if (pn < 20) { dst = V3; ld = 512; colt = (pn - 18) * 256; }
        else { dst = SG3; ld = D; colt = (pn - 20) * 256; act = true; }
        const int col0 = colt + wc * 32 + 8 * fq, r = u.pm * 256 + ai * 128 + wr * 64 + m * 16 + fr; const float rs = rstd_from_ssq(pr.s) * sc;
#pragma unroll
        for (int bj = 0; bj < 2; ++bj) {
            f32x4 v0 = a[bj][0] * rs, v1 = a[bj][1] * rs;
            if (act) {
#pragma unroll
                for (int j = 0; j < 4; ++j) { v0[j] = silu_f(v0[j]); v1[j] = silu_f(v1[j]); } }
            if (pn >= 16 && pn < 20) *(u32x4*)(dst + (size_t)r * ld + col0 + bj * 128) = pack8(v0, v1);
            else *(u32x4*)(dst + (size_t)r * ld + col0 + bj * 128) = pack8(v0, v1);
        }
    }
};

struct EpiDummy { float* out;
    struct Pre { int z; };
    __device__ __forceinline__ Pre pre(const pg8::Unit& u, int ai, int m, int wr, int wc, int fr, int fq) const { Pre p; p.z = 0; return p; }
    __device__ __forceinline__ void rows(Acc4 a, const Pre& pr, const pg8::Unit& u, int ai, int m, int wr, int wc, int fr, int fq) const {
        *(f32x4*)(out + ((size_t)(blockIdx.x * 512 + threadIdx.x) * 8 + ai * 4 + m) * 4) = (a[0][0] + a[0][1]) + (a[1][0] + a[1][1]); }
};
struct Args { const float* in[17]; float* out; unsigned char* ws; int ph_lo, ph_hi, sync, sub; };
enum { I_XP = 0, I_XS, I_STATE, I_CK, I_CV, I_META, I_RELB, I_HGLB, I_HGNORM, I_HGWIN, I_HGONORM, I_HGWOUT, I_SWNORM, I_SWWIN, I_SWSINK, I_SWWOUT, I_FNORM };

constexpr int WSCR = 64 * 132;
__device__ __forceinline__ float wave_sum(float v) {
#pragma unroll
    for (int o = 1; o < 64; o <<= 1) v += __shfl_xor(v, o);
    return v;
}
struct WItem { const float* src; const float* scl; bf16_t* dst; int N; bool nt; };
constexpr int WC1 = N1 / 64, WC2 = N2 / 64, WC3 = N3 / 64, WC4 = N4 / 64, WCT = WC1 + WC2 + WC3 + WC4;
__device__ __forceinline__ WItem w_resolve(const Args& a, int cb, int kb, int lane) {
    unsigned char* ws = a.ws; const float* W; const float* scale; bf16_t* Wt; int N; bool qf = false, late = false;
    if (cb < WC1) { W = a.in[I_HGWIN]; N = N1; Wt = (bf16_t*)(ws + WS_W1); scale = a.in[I_HGNORM]; qf = true; }
    else if (cb < WC1 + WC2) { cb -= WC1; W = a.in[I_HGWOUT]; N = N2; Wt = (bf16_t*)(ws + WS_W2); scale = a.in[I_HGONORM]; }
    else if (cb < WC1 + WC2 + WC3) { cb -= WC1 + WC2; W = a.in[I_SWWIN]; N = N3; Wt = (bf16_t*)(ws + WS_W3); scale = a.in[I_SWNORM]; late = true; }
    else { cb -= WC1 + WC2 + WC3; W = a.in[I_SWWOUT]; N = N4; Wt = (bf16_t*)(ws + WS_W4); scale = nullptr; late = true; }
    const int ocb = cb * 64; int lcb = ocb;
    if (qf && ocb < 8192) lcb = ((ocb >> 7) & 31) * 256 + (ocb >> 12) * 128 + (ocb & 127);
    const int cgp = lane & 15, kq = lane >> 4;
    WItem it; it.N = N; it.nt = late;
    it.src = W + (size_t)(kb * 64 + 2 * kq) * N + ocb + 4 * cgp;
    it.scl = scale ? scale + kb * 64 + 2 * kq : nullptr;
    it.dst = Wt + (size_t)lcb * LDK + kb * 64 + 8 * (lane & 7);
    return it;
}
__device__ __forceinline__ void w_load(const WItem& it, f32x4 (&v)[16], f32x2 (&sc)[8]) {
#pragma unroll
    for (int i = 0; i < 8; ++i) sc[i] = it.scl ? *(const f32x2*)(it.scl + 8 * i) : (f32x2){1.f, 1.f};
#pragma unroll
    for (int i = 0; i < 8; ++i) { v[2 * i] = __builtin_nontemporal_load((const f32x4*)(it.src + (size_t)(8 * i) * it.N)); v[2 * i + 1] = __builtin_nontemporal_load((const f32x4*)(it.src + (size_t)(8 * i + 1) * it.N)); }
}
__device__ __forceinline__ void w_finish(const WItem& it, const f32x4 (&v)[16], const f32x2 (&sc)[8], int lane, LAS unsigned char* scr) {
    const int cgp = lane & 15, kq = lane >> 4;
#pragma unroll
    for (int i = 0; i < 8; ++i) {
#pragma unroll
        for (int jj = 0; jj < 4; ++jj) *(LAS unsigned*)(scr + (4 * cgp + jj) * 132 + (8 * i + 2 * kq) * 2) = pk2(v[2 * i][jj] * sc[i].x, v[2 * i + 1][jj] * sc[i].y);
    }
#pragma unroll
    for (int j = 0; j < 8; ++j) {
        const int rr = (lane >> 3) + 8 * j, c = (rr & ~31) + perm32(rr & 31);
        LAS unsigned char* p = scr + c * 132 + (lane & 7) * 16;
        u32x4 w; w.x = *(LAS unsigned*)p; w.y = *(LAS unsigned*)(p + 4); w.z = *(LAS unsigned*)(p + 8); w.w = *(LAS unsigned*)(p + 12);
        if (it.nt) __builtin_nontemporal_store(w, (u32x4*)(it.dst + (size_t)rr * LDK)); else *(u32x4*)(it.dst + (size_t)rr * LDK) = w;
    }
}
__device__ __forceinline__ void w_convert1(const Args& a, int first, int end, int step, int ncb, int cb0, int lane, LAS unsigned char* scr) {
    for (int it = first; it < end; it += step) {
        f32x4 va[16]; f32x2 sa[8];
        const int kba = it / ncb; const WItem A = w_resolve(a, cb0 + (it - kba * ncb), kba, lane);
        w_load(A, va, sa); w_finish(A, va, sa, lane, scr);
    }
}
__device__ __forceinline__ void w_convert(const Args& a, int first, int end, int step, int ncb, int cb0, int lane, LAS unsigned char* scr) {
    for (int it = first; it < end; it += 2 * step) {
        f32x4 va[16], vb[16]; f32x2 sa[8], sb[8];
        const int kba = it / ncb; const WItem A = w_resolve(a, cb0 + (it - kba * ncb), kba, lane);
        w_load(A, va, sa);
        const int it2 = it + step; const bool hasB = it2 < end;
        const int kbb = hasB ? it2 / ncb : kba; const WItem B = w_resolve(a, cb0 + (hasB ? it2 - kbb * ncb : it - kba * ncb), kbb, lane);
        if (hasB) w_load(B, vb, sb);
        w_finish(A, va, sa, lane, scr);
        if (hasB) w_finish(B, vb, sb, lane, scr);
    }
}
__device__ __forceinline__ void p0_prep(const Args& a, int G, LAS unsigned char* lds) {
    const int tid = opaque_tid(), lane = tid & 63, wave = tid >> 6;
    const int gw = blockIdx.x * 8 + wave, NGW = G * 8;
    unsigned char* ws = a.ws;
    {   const int CT = (G == 256) ? WC1 : WCT;
        LAS unsigned char* scr = lds + wave * WSCR;
        w_convert(a, gw, CT * 64, NGW, CT, 0, lane, scr);
    }
    bf16_t* XB0 = (bf16_t*)(ws + WS_B0); float* RSTD0 = (float*)(ws + WS_RSTD0);
    {   const int r0 = gw, rstep = NGW;
        for (int r = r0; r < MP; r += rstep) {
            const float* src = x0_row(a.in[I_XP], a.in[I_XS], a.in[I_META], r);
            bf16_t* dst = XB0 + (size_t)r * LDK;
            if (!src) { for (int j = 0; j < 8; ++j) *(u32x4*)(dst + j * 512 + lane * 8) = (u32x4){0u, 0u, 0u, 0u}; if (lane == 0) RSTD0[r] = 0.f; continue; }
            float ss = 0.f;
#pragma unroll
            for (int j = 0; j < 8; ++j) {
                const f32x4 v0 = __builtin_nontemporal_load((const f32x4*)(src + j * 512 + lane * 8)), v1 = __builtin_nontemporal_load((const f32x4*)(src + j * 512 + lane * 8 + 4));
                ss += (v0[0] * v0[0] + v0[1] * v0[1]) + (v0[2] * v0[2] + v0[3] * v0[3]) + (v1[0] * v1[0] + v1[1] * v1[1]) + (v1[2] * v1[2] + v1[3] * v1[3]);
                *(u32x4*)(dst + j * 512 + lane * 8) = pack8(v0, v1);
            }
            ss = wave_sum(ss);
            if (lane == 0) RSTD0[r] = rsqrtf(ss * (1.0f / D) + EPS);
        }
    }
    const int gt = blockIdx.x * 512 + tid, NGT = G * 512;
    float* LB = (float*)(ws + WS_LB); float* BT = (float*)(ws + WS_BT);
    for (int i = gt; i < D; i += NGT) {
        const float x0 = a.in[I_HGLB][i], x1 = a.in[I_HGLB][D + i], x2 = a.in[I_HGLB][2 * D + i];
        const float mx = fmaxf(x0, fmaxf(x1, x2)); const float e0 = expf(x0 - mx), e1 = expf(x1 - mx), e2 = expf(x2 - mx);
        LB[i] = e0 / (e0 + e1 + e2);
    }
    for (int i = gt; i < 64 * 129; i += NGT) {
        const int h = i / 129, dist = i - h * 129; int bucket;
        if (dist < 16) bucket = dist;
        else { const float dd = (float)dist; int large = 16 + (int)(logf(dd / 16.0f) / 2.0794415416798357f * 16.0f); bucket = large < 31 ? large : 31; }
        BT[h * 132 + dist] = a.in[I_RELB][bucket * 64 + h] * 1.4426950408889634f;
    }
}

__device__ __forceinline__ s16x4 ds_tr16(LAS unsigned char* p) { return __builtin_bit_cast(s16x4, __builtin_amdgcn_ds_read_tr16_b64_v4i16((LAS s16x4*)p)); }
__device__ __forceinline__ bf16x8 mk8(u32x2 lo, u32x2 hi) { u32x4 w = {lo.x, lo.y, hi.x, hi.y}; return __builtin_bit_cast(bf16x8, w); }
__device__ __forceinline__ bf16x8 mk8z(s16x4 t) { bf16x8 r = {t[0], t[1], t[2], t[3], 0, 0, 0, 0}; return r; }

struct HgRegs { u32x2 q0, k0, v0, sg0, q1, k1, v1, sg1; f32x4 e0, e1; };
struct HgCtx { const char *QT, *KT, *V, *SG, *EB; char* A2; unsigned toff, eoff, aoff; int tid, w, lv, g, srow, sseg; };
constexpr int HG_NSTEP = (NCHUNK + 1) / 2;
constexpr int HG_RS = 272, HG_RN = 288, HG_TILE = 16 * HG_RN;
constexpr int HG_BUF = 10 * HG_TILE + 512, HG_OB_OFF = 2 * HG_BUF, HG_OROW = 132 * 4, HG_OBUF = 32 * HG_OROW, HG_SQ_OFF = HG_OB_OFF + 2 * HG_OBUF;
static_assert(HG_SQ_OFF + 2 * 32 * 8 * 4 <= MISC_OFF, "recurrence LDS map");
__device__ __forceinline__ u32x2 scale4(u32x2 w, const f32x4& e) { u32x2 r; r.x = pk2(bf_lo(w.x) * e[0], bf_hi(w.x) * e[1]); r.y = pk2(bf_lo(w.y) * e[2], bf_hi(w.y) * e[3]); return r; }
__device__ __forceinline__ void hg_load(HgRegs& r, const HgCtx& x, int p) {
    const size_t cs = (size_t)p * (32 * 128 * 2);
    const bool has1 = 2 * p + 1 < NCHUNK;
    const size_t c1 = cs + (has1 ? 16 * 128 * 2 : 0), ce = (size_t)p * (2 * 128 * 4), ce1 = ce + (has1 ? 128 * 4 : 0);
    r.q0 = *(const u32x2*)(x.QT + cs + x.toff); r.k0 = *(const u32x2*)(x.KT + cs + x.toff); r.v0 = *(const u32x2*)(x.V + cs + x.toff); r.sg0 = *(const u32x2*)(x.SG + cs + x.toff);
    r.e0 = *(const f32x4*)(x.EB + ce + x.eoff);
    r.q1 = *(const u32x2*)(x.QT + c1 + x.toff); r.k1 = *(const u32x2*)(x.KT + c1 + x.toff); r.v1 = *(const u32x2*)(x.V + c1 + x.toff); r.sg1 = *(const u32x2*)(x.SG + c1 + x.toff);
    r.e1 = *(const f32x4*)(x.EB + ce1 + x.eoff);
}
__device__ __forceinline__ void hg_fix_last(HgRegs& r, int p) {
    if (2 * p + 1 >= NCHUNK) { const u32x2 z = {0u, 0u}; r.q1 = z; r.k1 = z; r.v1 = z; r.e1 = (f32x4){1.f, 1.f, 1.f, 1.f}; }
}
__device__ __forceinline__ void hg_store(const HgRegs& r, const HgCtx& x, LAS unsigned char* lds, int bi) {
    LAS unsigned char* bn = lds + bi * HG_BUF + x.srow * HG_RN + x.sseg * 8;
    LAS unsigned char* bp = lds + bi * HG_BUF + x.srow * HG_RS + (32 * (x.sseg >> 3) + 8 * (x.sseg & 3) + 4 * ((x.sseg >> 2) & 1)) * 2;
    const f32x4 e01 = r.e0 * r.e1;
    *(LAS u32x2*)(bp) = r.q0; *(LAS u32x2*)(bp + HG_TILE) = r.k0; *(LAS u32x2*)(bn + 3 * HG_TILE) = r.v0;
    *(LAS u32x2*)(bp + 4 * HG_TILE) = r.q1; *(LAS u32x2*)(bp + 5 * HG_TILE) = r.k1; *(LAS u32x2*)(bn + 6 * HG_TILE) = scale4(r.k1, r.e1); *(LAS u32x2*)(bn + 7 * HG_TILE) = r.v1;
    *(LAS u32x2*)(bp + 8 * HG_TILE) = scale4(r.q1, r.e0); *(LAS u32x2*)(bn + 9 * HG_TILE) = scale4(r.k0, e01);
    if (x.srow == 0) *(LAS f32x4*)(lds + bi * HG_BUF + 10 * HG_TILE + x.sseg * 16) = e01;
}
__device__ __forceinline__ void hg_frags(bf16x8 (&f)[4], LAS unsigned char* tile, int lv, int g) {
#pragma unroll
    for (int p = 0; p < 4; ++p) f[p] = *(LAS bf16x8*)(tile + lv * HG_RS + (32 * p + 8 * g) * 2);
}
__device__ __forceinline__ f32x4 hg_dot4(const bf16x8 (&a)[4], const bf16x8 (&b)[4]) {
    f32x4 x = {0.f, 0.f, 0.f, 0.f}, y = {0.f, 0.f, 0.f, 0.f};
    x = __builtin_amdgcn_mfma_f32_16x16x32_bf16(a[0], b[0], x, 0, 0, 0); y = __builtin_amdgcn_mfma_f32_16x16x32_bf16(a[1], b[1], y, 0, 0, 0);
    x = __builtin_amdgcn_mfma_f32_16x16x32_bf16(a[2], b[2], x, 0, 0, 0); y = __builtin_amdgcn_mfma_f32_16x16x32_bf16(a[3], b[3], y, 0, 0, 0);
    return x + y;
}
__device__ __forceinline__ void hg_step(f32x4 (&S)[8], HgRegs& RL, HgRegs& RS, u32x2& sgc0, u32x2& sgc1, const HgCtx& x, LAS unsigned char* lds, int p) {
    const int cb = p & 1, w = x.w, lv = x.lv, g = x.g;
    hg_load(RL, x, p + 2 < HG_NSTEP ? p + 2 : HG_NSTEP - 1);
    LAS unsigned char* base = lds + cb * HG_BUF;
    bf16x8 sb[4];
#pragma unroll
    for (int q = 0; q < 4; ++q) { u32x4 sw = {pk2(S[2 * q][0], S[2 * q][1]), pk2(S[2 * q][2], S[2 * q][3]), pk2(S[2 * q + 1][0], S[2 * q + 1][1]), pk2(S[2 * q + 1][2], S[2 * q + 1][3])}; sb[q] = __builtin_bit_cast(bf16x8, sw); }
    const s16x4 vb0 = ds_tr16(base + 3 * HG_TILE + (4 * g + (lv >> 2)) * HG_RN + (16 * w + 4 * (lv & 3)) * 2);
    const s16x4 vb1 = ds_tr16(base + 7 * HG_TILE + (4 * g + (lv >> 2)) * HG_RN + (16 * w + 4 * (lv & 3)) * 2);
    const bf16x8 vb01 = {vb0[0], vb0[1], vb0[2], vb0[3], vb1[0], vb1[1], vb1[2], vb1[3]};
    f32x4 O0, O1;
    bf16x8 ka[4]; hg_frags(ka, base + HG_TILE, lv, g);
    {
        bf16x8 qf[4]; hg_frags(qf, base, lv, g);
        f32x4 X = hg_dot4(ka, qf);
        O0 = hg_dot4(qf, sb);
#pragma unroll
        for (int i = 0; i < 4; ++i) X[i] = (4 * g + i <= lv) ? X[i] : 0.f;
        s16x4 xa; { u32x2 wv = {pk2(X[0], X[1]), pk2(X[2], X[3])}; xa = __builtin_bit_cast(s16x4, wv); }
        O0 = __builtin_amdgcn_mfma_f32_16x16x16bf16_1k(xa, vb0, O0, 0, 0, 0);
    }
    {
        bf16x8 qf[4], kf[4], qs[4]; hg_frags(qf, base + 4 * HG_TILE, lv, g); hg_frags(kf, base + 5 * HG_TILE, lv, g); hg_frags(qs, base + 8 * HG_TILE, lv, g);
        f32x4 Xb = hg_dot4(kf, qf); const f32x4 Xa = hg_dot4(ka, qs);
        O1 = hg_dot4(qs, sb);
#pragma unroll
        for (int i = 0; i < 4; ++i) Xb[i] = (4 * g + i <= lv) ? Xb[i] : 0.f;
        u32x4 wv = {pk2(Xa[0], Xa[1]), pk2(Xa[2], Xa[3]), pk2(Xb[0], Xb[1]), pk2(Xb[2], Xb[3])};
        O1 = __builtin_amdgcn_mfma_f32_16x16x32_bf16(__builtin_bit_cast(bf16x8, wv), vb01, O1, 0, 0, 0);
    }
#pragma unroll
    for (int kt = 0; kt < 8; ++kt) {
        const f32x4 e4 = *(LAS f32x4*)(base + 10 * HG_TILE + (16 * kt + 4 * g) * 4);
        const s16x4 ka = ds_tr16(base + 9 * HG_TILE + (4 * g + (lv >> 2)) * HG_RN + (16 * kt + 4 * (lv & 3)) * 2);
        const s16x4 kb = ds_tr16(base + 6 * HG_TILE + (4 * g + (lv >> 2)) * HG_RN + (16 * kt + 4 * (lv & 3)) * 2);
        const bf16x8 kab = {ka[0], ka[1], ka[2], ka[3], kb[0], kb[1], kb[2], kb[3]};
        S[kt] = S[kt] * e4;
        S[kt] = __builtin_amdgcn_mfma_f32_16x16x32_bf16(kab, vb01, S[kt], 0, 0, 0);
    }
    {   LAS unsigned char* ob = lds + HG_OB_OFF + cb * HG_OBUF + (16 * w + lv) * 4;
#pragma unroll
        for (int i = 0; i < 4; ++i) { *(LAS float*)(ob + (4 * g + i) * HG_OROW) = O0[i]; *(LAS float*)(ob + (16 + 4 * g + i) * HG_OROW) = O1[i]; }
        f32x4 q0 = O0 * O0, q1 = O1 * O1;
#pragma unroll
        for (int i = 0; i < 4; ++i) { q0[i] = row_sum16(q0[i]); q1[i] = row_sum16(q1[i]); }
        if (lv == 0) {
#pragma unroll
            for (int i = 0; i < 4; ++i) { *(LAS float*)(lds + HG_SQ_OFF + ((cb * 32 + 4 * g + i) * 8 + w) * 4) = q0[i]; *(LAS float*)(lds + HG_SQ_OFF + ((cb * 32 + 16 + 4 * g + i) * 8 + w) * 4) = q1[i]; } }
    }
    if (p + 1 < HG_NSTEP) { hg_fix_last(RS, p + 1); hg_store(RS, x, lds, cb ^ 1); }
    const u32x2 sgn0 = RS.sg0, sgn1 = RS.sg1;
    __syncthreads();
#pragma unroll
    for (int j = 0; j < 2; ++j) {
        if (j == 1 && 2 * p + 1 >= NCHUNK) break;
        const int trow = 16 * j + x.srow;
        const f32x4 o4 = *(LAS f32x4*)(lds + HG_OB_OFF + cb * HG_OBUF + trow * HG_OROW + x.sseg * 16);
        const f32x4 pa = *(LAS f32x4*)(lds + HG_SQ_OFF + (cb * 32 + trow) * 32), pb = *(LAS f32x4*)(lds + HG_SQ_OFF + (cb * 32 + trow) * 32 + 16);
        const float ss = ((pa[0] + pa[1]) + (pa[2] + pa[3])) + ((pb[0] + pb[1]) + (pb[2] + pb[3]));
        const float rstd = rsqrtf(ss * (1.0f / 128.0f) + EPS);
        const u32x2 sg = j ? sgc1 : sgc0;
        u32x2 ov; ov.x = pk2(o4[0] * rstd * bf_lo(sg.x), o4[1] * rstd * bf_hi(sg.x)); ov.y = pk2(o4[2] * rstd * bf_lo(sg.y), o4[3] * rstd * bf_hi(sg.y));
        *(u32x2*)(x.A2 + (size_t)(2 * p + j) * (16 * LDK * 2) + x.aoff) = ov;
    }
    sgc0 = sgn0; sgc1 = sgn1;
}
__device__ __forceinline__ void hg_prompt_unit(LAS unsigned char* lds, int b, int h, const bf16_t* QT, const bf16_t* KT, const bf16_t* KD, const bf16_t* V, const bf16_t* SG, const float* EBL, bf16_t* A2, float* outS) {
    HgCtx x;
    x.tid = opaque_tid(); const int lane = x.tid & 63; x.w = __builtin_amdgcn_readfirstlane(x.tid >> 6); x.lv = lane & 15; x.g = lane >> 4; x.srow = x.tid >> 5; x.sseg = x.tid & 31;
    const size_t rowbase = (size_t)b * TP; const int colbase = h * 128;
    {   const size_t ub = (size_t)(b * 32 + h) * TP * 128 * 2;
        x.QT = (const char*)QT + ub; x.KT = (const char*)KT + ub; x.V = (const char*)V + ub; x.SG = (const char*)SG + ub;
        x.A2 = (char*)A2 + (rowbase * LDK + colbase) * 2;
        x.EB = (const char*)EBL + (size_t)(b * 32 + h) * NCHUNK * 128 * 4;
        x.toff = (unsigned)x.tid * 8u; x.eoff = (unsigned)(4 * x.sseg) * 4u; x.aoff = (unsigned)(x.srow * LDK + 4 * x.sseg) * 2u; }
    f32x4 S[8];
#pragma unroll
    for (int i = 0; i < 8; ++i) S[i] = (f32x4){0.f, 0.f, 0.f, 0.f};
    HgRegs R0, R1;
    hg_load(R0, x, 0); hg_store(R0, x, lds, 0); u32x2 sgc0 = R0.sg0, sgc1 = R0.sg1; hg_load(R1, x, 1);
    __syncthreads();
    for (int p = 0; p < HG_NSTEP; p += 2) {
        hg_step(S, R0, R1, sgc0, sgc1, x, lds, p);
        if (p + 1 < HG_NSTEP) hg_step(S, R1, R0, sgc0, sgc1, x, lds, p + 1);
    }
    float* so = outS + ((size_t)(b * 32 + h) * 128) * 128 + 16 * x.w + x.lv;
#pragma unroll
    for (int kt = 0; kt < 8; ++kt)
#pragma unroll
        for (int i = 0; i < 4; ++i) so[(size_t)(16 * kt + 4 * x.g + i) * 128] = S[kt][i];
    __syncthreads();
}
__device__ __forceinline__ void hg_sample_unit(LAS unsigned char* lds, int s, int h, const bf16_t* QT, const bf16_t* KT, const bf16_t* KD, const bf16_t* V, const bf16_t* SG, const float* S0, float* S1, bf16_t* A2) {
    const int tid = opaque_tid(), kg = tid >> 5, c4 = tid & 31;
    const size_t ro = ((size_t)BATCH * 32 * TP + (size_t)s * 32 + h) * 128;
    const u32x4 qw = *(const u32x4*)(QT + ro + 8 * kg), kw = *(const u32x4*)(KT + ro + 8 * kg);
    const u32x2 vw = *(const u32x2*)(V + ro + 4 * c4);
    const f32x4 v4 = {bf_lo(vw.x), bf_hi(vw.x), bf_lo(vw.y), bf_hi(vw.y)};
    float qv[8] = {bf_lo(qw.x), bf_hi(qw.x), bf_lo(qw.y), bf_hi(qw.y), bf_lo(qw.z), bf_hi(qw.z), bf_lo(qw.w), bf_hi(qw.w)};
    float kv[8] = {bf_lo(kw.x), bf_hi(kw.x), bf_lo(kw.y), bf_hi(kw.y), bf_lo(kw.z), bf_hi(kw.z), bf_lo(kw.w), bf_hi(kw.w)};
    float fv[8];
#pragma unroll
    for (int i = 0; i < 8; ++i) fv[i] = 1.0f - kv[i];
    const size_t so = (((size_t)s * 32 + h) * 128 + 8 * kg) * 128 + 4 * c4;
    f32x4 oa = {0.f, 0.f, 0.f, 0.f};
#pragma unroll
    for (int i = 0; i < 8; ++i) { const f32x4 s4 = __builtin_nontemporal_load((const f32x4*)(S0 + so + i * 128)); const f32x4 n4 = s4 * fv[i] + v4 * kv[i]; __builtin_nontemporal_store(n4, (f32x4*)(S1 + so + i * 128)); oa += n4 * qv[i]; }
    *(LAS f32x4*)(lds + (kg * 128 + 4 * c4) * 4) = oa;
    __syncthreads();
    if (tid < 32) {
        f32x4 o4 = {0.f, 0.f, 0.f, 0.f};
#pragma unroll
        for (int k = 0; k < 16; ++k) o4 += *(LAS f32x4*)(lds + (k * 128 + 4 * tid) * 4);
        float ss = (o4[0] * o4[0] + o4[1] * o4[1]) + (o4[2] * o4[2] + o4[3] * o4[3]);
#pragma unroll
        for (int o = 1; o < 32; o <<= 1) ss += __shfl_xor(ss, o);
        const float rstd = rsqrtf(ss * (1.0f / 128.0f) + EPS);
        const u32x2 sg = *(const u32x2*)(SG + ro + 4 * tid);
        u32x2 ov; ov.x = pk2(o4[0] * rstd * bf_lo(sg.x), o4[1] * rstd * bf_hi(sg.x)); ov.y = pk2(o4[2] * rstd * bf_lo(sg.y), o4[3] * rstd * bf_hi(sg.y));
        *(u32x2*)(A2 + (size_t)(MPROMPT + s) * LDK + h * 128 + 4 * tid) = ov;
    }
    __syncthreads();
}

__device__ __forceinline__ u32x4 attn_ldblk(const bf16_t* K3, const bf16_t* V3, int b, int n, int tblk, int tid) {
    const int row = tid >> 4, ch = tid & 15, tok = 32 * tblk + row; u32x4 v = {0u, 0u, 0u, 0u};
    if (tok >= 0 && tok < TP) { const size_t o = ((size_t)b * TP + tok) * 512 + n * 64 + (ch & 7) * 8; v = *(const u32x4*)((ch < 8 ? K3 : V3) + o); }
    return v;
}
constexpr int AT_KR = 144, AT_KOFF = 0, AT_VOFF = 6 * 32 * AT_KR, AT_BTOFF = 2 * AT_VOFF, AT_DOFF = AT_BTOFF + 8 * 192 * 4, AT_OOFF = AT_DOFF + 8 * 32 * 4, AT_OROW = 272, AT_OWAVE = 32 * AT_OROW;
static_assert(AT_OOFF + 8 * AT_OWAVE <= MISC_OFF && AT_OOFF % 16 == 0, "attention LDS map");
__device__ __forceinline__ void attn_stblk(LAS unsigned char* lds, u32x4 v, int tblk, int tid) {
    const int row = tid >> 4, ch = tid & 15, slot = (tblk + 8) % 6;
    *(LAS u32x4*)(lds + (ch < 8 ? AT_KOFF : AT_VOFF) + (slot * 32 + row) * AT_KR + (ch & 7) * 16) = v;
}
__device__ __forceinline__ void attn_ldq(bf16x8 (&qf)[4], const bf16_t* Q3, int b, int h, int qb, int q, int hh) {
    const int tq = (32 * qb + q < TP) ? 32 * qb + q : TP - 1; const bf16_t* qp = Q3 + ((size_t)b * TP + tq) * D + h * 64 + 8 * hh;
#pragma unroll
    for (int ds = 0; ds < 4; ++ds) qf[ds] = *(const bf16x8*)(qp + 16 * ds);
}
__device__ __forceinline__ void attn_prompt_run(LAS unsigned char* lds, int b, int n, int qlo, int qhi, const bf16_t* Q3, const bf16_t* K3, const bf16_t* V3, const bf16_t* SG3, const float* BT, const float* sinks, bf16_t* A4) {
    const int tid = opaque_tid(), lane = tid & 63, w = __builtin_amdgcn_readfirstlane(tid >> 6), q = lane & 31, hh = lane >> 5, lv = lane & 15, G = lane >> 4;
    const int h = 8 * n + w;
    {   u32x4 r5[5];
#pragma unroll
        for (int k = 0; k < 5; ++k) r5[k] = attn_ldblk(K3, V3, b, n, qlo - 4 + k, tid);
#pragma unroll
        for (int k = 0; k < 5; ++k) attn_stblk(lds, r5[k], qlo - 4 + k, tid); }
    for (int i = tid; i < 8 * 192; i += 512) { const int x = i / 192, idx = i - x * 192, dist = 159 - idx;
        *(LAS float*)(lds + AT_BTOFF + i * 4) = (dist >= 0 && dist <= WIN) ? BT[(8 * n + x) * 132 + dist] : -1e30f; }
    u32x4 nreg = attn_ldblk(K3, V3, b, n, qlo + 1, tid);
    bf16x8 qn[4]; attn_ldq(qn, Q3, b, h, qlo, q, hh);
    const float sink = sinks[h] * 1.4426950408889634f;
    LAS unsigned char* tbp = lds + AT_BTOFF + (w * 192 + (31 - q) + 4 * hh) * 4;
    LAS unsigned char* ost = lds + AT_OOFF + w * AT_OWAVE;
    __syncthreads();
    for (int i = qlo; i < qhi; ++i) {
        const int t0 = 32 * i;
        if (i + 1 < qhi) attn_stblk(lds, nreg, i + 1, tid);
        if (i + 2 < qhi) nreg = attn_ldblk(K3, V3, b, n, i + 2, tid);
        bf16x8 qf[4];
#pragma unroll
        for (int ds = 0; ds < 4; ++ds) qf[ds] = qn[ds];
        if (i + 1 < qhi) attn_ldq(qn, Q3, b, h, i + 1, q, hh);
        u32x4 sgv[4];
#pragma unroll
        for (int it = 0; it < 4; ++it) { const int tq = t0 + it * 8 + (lane >> 3); sgv[it] = (u32x4){0u, 0u, 0u, 0u}; if (tq < TP) sgv[it] = *(const u32x4*)(SG3 + ((size_t)b * TP + tq) * D + h * 64 + (lane & 7) * 8); }
        int so[5];
#pragma unroll
        for (int kb = 0; kb < 5; ++kb) so[kb] = ((i - 4 + kb + 8) % 6) * 32 * AT_KR;
        f32x16 p[5];
#pragma unroll
        for (int kb = 0; kb < 5; ++kb) {
#pragma unroll
            for (int r = 0; r < 16; ++r) p[kb][r] = *(LAS float*)(tbp + (32 * kb + (r & 3) + 8 * (r >> 2)) * 4);
#pragma unroll
            for (int ds = 0; ds < 4; ++ds) { const bf16x8 kf = *(LAS bf16x8*)(lds + AT_KOFF + so[kb] + q * AT_KR + (16 * ds + 8 * hh) * 2); p[kb] = __builtin_amdgcn_mfma_f32_32x32x16_bf16(kf, qf[ds], p[kb], 0, 0, 0); }
        }
        if (t0 < 128) {
            const int jmin = 128 - t0 - 4 * hh;
#pragma unroll
            for (int kb = 0; kb < 4; ++kb)
#pragma unroll
                for (int r = 0; r < 16; ++r) { const int jc = 32 * kb + (r & 3) + 8 * (r >> 2); p[kb][r] = (jc >= jmin) ? p[kb][r] : -1e30f; }
        }
        float mx = sink;
#pragma unroll
        for (int kb = 0; kb < 5; ++kb)
#pragma unroll
            for (int r = 0; r < 16; r += 2) mx = fmaxf(mx, fmaxf(p[kb][r], p[kb][r + 1]));
        mx = fmaxf(mx, __shfl_xor(mx, 32));
        float sum = 0.f;
#pragma unroll
        for (int kb = 0; kb < 5; ++kb)
#pragma unroll
            for (int r = 0; r < 16; ++r) { const float e = __builtin_amdgcn_exp2f(p[kb][r] - mx); p[kb][r] = e; sum += e; }
        sum += __shfl_xor(sum, 32);
        const float rden = 1.0f / (sum + __builtin_amdgcn_exp2f(sink - mx));
        if (hh == 0) *(LAS float*)(lds + AT_DOFF + (w * 32 + q) * 4) = rden;
        f32x16 o[2];
#pragma unroll
        for (int r = 0; r < 16; ++r) { o[0][r] = 0.f; o[1][r] = 0.f; }
#pragma unroll
        for (int kb = 0; kb < 5; ++kb)
#pragma unroll
            for (int ks = 0; ks < 2; ++ks) {
                u32x4 pw = {pk2(p[kb][8 * ks + 0], p[kb][8 * ks + 1]), pk2(p[kb][8 * ks + 2], p[kb][8 * ks + 3]), pk2(p[kb][8 * ks + 4], p[kb][8 * ks + 5]), pk2(p[kb][8 * ks + 6], p[kb][8 * ks + 7])};
                const bf16x8 pa = __builtin_bit_cast(bf16x8, pw);
                const int rowb = 16 * ks + 4 * hh + (lv >> 2);
#pragma unroll
                for (int db = 0; db < 2; ++db) {
                    LAS unsigned char* vp = lds + AT_VOFF + so[kb] + rowb * AT_KR + (32 * db + 16 * (G & 1) + 4 * (lv & 3)) * 2;
                    const s16x4 t0v = ds_tr16(vp), t1v = ds_tr16(vp + 8 * AT_KR);
                    const bf16x8 vb = {t0v[0], t0v[1], t0v[2], t0v[3], t1v[0], t1v[1], t1v[2], t1v[3]};
                    o[db] = __builtin_amdgcn_mfma_f32_32x32x16_bf16(pa, vb, o[db], 0, 0, 0);
                }
            }
#pragma unroll
        for (int db = 0; db < 2; ++db)
#pragma unroll
            for (int r = 0; r < 16; ++r) *(LAS float*)(ost + ((r & 3) + 8 * (r >> 2) + 4 * hh) * AT_OROW + (32 * db + q) * 4) = o[db][r];
#pragma unroll
        for (int it = 0; it < 4; ++it) {
            const int row = it * 8 + (lane >> 3), ch = lane & 7, tq = t0 + row;
            const f32x4 a0 = *(LAS f32x4*)(ost + row * AT_OROW + ch * 32), a1 = *(LAS f32x4*)(ost + row * AT_OROW + ch * 32 + 16);
            const float rd = *(LAS float*)(lds + AT_DOFF + (w * 32 + row) * 4);
            if (tq < TP) {
                const u32x4 sg = sgv[it];
                u32x4 ov;
                ov.x = pk2(a0[0] * rd * bf_lo(sg.x), a0[1] * rd * bf_hi(sg.x)); ov.y = pk2(a0[2] * rd * bf_lo(sg.y), a0[3] * rd * bf_hi(sg.y));
                ov.z = pk2(a1[0] * rd * bf_lo(sg.z), a1[1] * rd * bf_hi(sg.z)); ov.w = pk2(a1[2] * rd * bf_lo(sg.w), a1[3] * rd * bf_hi(sg.w));
                *(u32x4*)(A4 + ((size_t)b * TP + tq) * LDK + h * 64 + ch * 8) = ov;
            }
        }
        __syncthreads();
    }
}
__device__ __forceinline__ void attn_sample_unit(LAS unsigned char* lds, int s, int n, const bf16_t* Q3, const bf16_t* K3, const bf16_t* V3, const bf16_t* SG3, const float* BT, const float* sinks,
                                                 const float* ck, const float* cv, float* oks, float* ovs, bf16_t* A4) {
    const int tid = opaque_tid(), lane = tid & 63, w = __builtin_amdgcn_readfirstlane(tid >> 6);
    constexpr int KS = 0, VS = 33792, QS = 67584, PS = 69632;
    LAS float* ksm = (LAS float*)(lds + KS); LAS float* vsm = (LAS float*)(lds + VS); LAS float* qsm = (LAS float*)(lds + QS); LAS float* psm = (LAS float*)(lds + PS);
    const int r = MPROMPT + s, h = 8 * n + w;
    for (int i = tid; i < 128 * 16; i += 512) {
        const int row = i >> 4, c4 = i & 15; const size_t o = (((size_t)s * 128 + row) * 8 + n) * 64 + 4 * c4;
        const f32x4 k4 = *(const f32x4*)(ck + o), v4 = *(const f32x4*)(cv + o);
#pragma unroll
        for (int j = 0; j < 4; ++j) { ksm[row * 65 + 4 * c4 + j] = k4[j]; vsm[row * 65 + 4 * c4 + j] = v4[j]; }
    }
    if (tid < 64) { ksm[128 * 65 + tid] = bf1(K3[(size_t)r * 512 + n * 64 + tid]); vsm[128 * 65 + tid] = bf1(V3[(size_t)r * 512 + n * 64 + tid]); }
    qsm[w * 64 + lane] = bf1(Q3[(size_t)r * D + h * 64 + lane]);
    __syncthreads();
    for (int i = tid; i < 128 * 64; i += 512) { const int rr = i >> 6, d = i & 63; const size_t o = (((size_t)s * 128 + rr) * 8 + n) * 64 + d; oks[o] = ksm[(rr + 1) * 65 + d]; ovs[o] = vsm[(rr + 1) * 65 + d]; }
    float s0 = 0.f, s1 = 0.f, s2 = 0.f;
    for (int d = 0; d < 64; ++d) { const float qd = qsm[w * 64 + d]; s0 += qd * ksm[lane * 65 + d]; s1 += qd * ksm[(lane + 64) * 65 + d]; s2 += qd * ksm[128 * 65 + d]; }
    s0 += BT[h * 132 + (128 - lane)]; s1 += BT[h * 132 + (64 - lane)]; s2 += BT[h * 132];
    float mx = fmaxf(s0, fmaxf(s1, s2));
#pragma unroll
    for (int o = 1; o < 64; o <<= 1) mx = fmaxf(mx, __shfl_xor(mx, o));
    const float sink = sinks[h] * 1.4426950408889634f; mx = fmaxf(mx, sink);
    const float p0 = __builtin_amdgcn_exp2f(s0 - mx), p1 = __builtin_amdgcn_exp2f(s1 - mx), p2 = __builtin_amdgcn_exp2f(s2 - mx);
    float sum = wave_sum(p0 + p1) + p2;
    const float rden = 1.0f / (sum + __builtin_amdgcn_exp2f(sink - mx));
    psm[w * 132 + lane] = p0; psm[w * 132 + 64 + lane] = p1; if (lane == 0) psm[w * 132 + 128] = p2;
    float oa = 0.f;
    for (int j = 0; j < 129; ++j) oa += psm[w * 132 + j] * vsm[j * 65 + lane];
    const size_t go = (size_t)r * D + h * 64 + lane;
    const float outv = oa * rden * bf1(SG3[go]);
    A4[(size_t)r * LDK + h * 64 + lane] = (bf16_t)(pk2(outv, 0.f) & 0xffffu);
    __syncthreads();
}


#define XB_TMO      128
#define XB_XCNT(j)  (256  + 64 * (j))
#define XB_XSUB(j)  (1280 + 64 * (j))
#define XB_XGEN(j)  (2304 + 64 * (j))
#define XB_TOP      3328
#define XB_TOPGEN   3392
#define XCD_BAR_WORDS 3456
#define XB_SPIN_CAP (1u << 20)
__device__ __forceinline__ unsigned xb_ld(unsigned* p)              { return __hip_atomic_load(p, __ATOMIC_RELAXED, __HIP_MEMORY_SCOPE_AGENT); }
__device__ __forceinline__ unsigned xb_add(unsigned* p, unsigned v) { return __hip_atomic_fetch_add(p, v, __ATOMIC_RELAXED, __HIP_MEMORY_SCOPE_AGENT); }
__device__ __forceinline__ unsigned xb_xcc_id() { return (unsigned)__builtin_amdgcn_s_getreg((3 << 11) | 20) & 0xFu; }
#define XB_SPIN(cond, bar) do { unsigned _sp = 0; while (cond) { __builtin_amdgcn_s_sleep(1); \
    if ((++_sp & 255u) == 0u) { if (xb_ld(&(bar)[XB_TMO])) break; if (_sp > XB_SPIN_CAP) { atomicAdd(&(bar)[XB_TMO], 1u); break; } } } } while (0)
struct XcdBarrier { unsigned* bar; unsigned x; volatile LAS unsigned* st; unsigned nloc, nx; };
__device__ __forceinline__ XcdBarrier xcd_barrier_post(unsigned* bar, volatile LAS unsigned* st) {
    XcdBarrier b; b.bar = bar; b.x = xb_xcc_id(); b.st = st; b.nloc = 0u; b.nx = 0u;
    if (threadIdx.x == 0) (void)xb_add(&bar[XB_XCNT(b.x)], 1u);
    return b;
}
__device__ __forceinline__ void xcd_barrier_complete(unsigned* bar, unsigned x, unsigned& nloc, unsigned& nx) {
    const unsigned G = gridDim.x * gridDim.y * gridDim.z;
    unsigned sum, cnt, mine, sp = 0u;
    for (;;) {
        sum = 0u; cnt = 0u; mine = 0u;
#pragma unroll
        for (unsigned j = 0; j < 16; ++j) { const unsigned c = xb_ld(&bar[XB_XCNT(j)]); sum += c; cnt += (c > 0u) ? 1u : 0u; mine = (j == x) ? c : mine; }
        if (sum == G) break;
        __builtin_amdgcn_s_sleep(1);
        if ((++sp & 255u) == 0u) { if (xb_ld(&bar[XB_TMO])) break; if (sp > XB_SPIN_CAP) { atomicAdd(&bar[XB_TMO], 1u); break; } }
    }
    nloc = mine > 0u ? mine : 1u; nx = cnt > 0u ? cnt : 1u;
}
__device__ __forceinline__ void xcd_barrier(XcdBarrier& b) {
    asm volatile("s_waitcnt vmcnt(0)" ::: "memory");
    __syncthreads();
    if (threadIdx.x == 0) {
        unsigned* bar = b.bar;
        __builtin_amdgcn_s_waitcnt(0);
        unsigned nloc = b.nloc, nx = b.nx;
        if (nloc == 0u) { xcd_barrier_complete(bar, b.x, nloc, nx); b.st[0] = nloc; b.st[1] = nx; }
        const unsigned old = xb_add(&bar[XB_XSUB(b.x)], 1u);
        const unsigned gen = old / nloc;
        if (old + 1u == (gen + 1u) * nloc) {
            __builtin_amdgcn_fence(__ATOMIC_RELEASE, "agent");
            asm volatile("s_waitcnt vmcnt(0)" ::: "memory");
            const unsigned og = xb_add(&bar[XB_TOP], 1u);
            const unsigned tg = og / nx;
            if (og + 1u == (tg + 1u) * nx) xb_add(&bar[XB_TOPGEN], 1u);
            else XB_SPIN(xb_ld(&bar[XB_TOPGEN]) == tg, bar);
            __builtin_amdgcn_fence(__ATOMIC_ACQUIRE, "agent");
            xb_add(&bar[XB_XGEN(b.x)], 1u);
            asm volatile("s_waitcnt vmcnt(0)" ::: "memory");
        } else {
            XB_SPIN(xb_ld(&bar[XB_XGEN(b.x)]) == gen, bar);
            __builtin_amdgcn_fence(__ATOMIC_ACQUIRE, "agent");
            asm volatile("s_waitcnt vmcnt(0)" ::: "memory");
        }
    }
    __syncthreads();
    if (b.nloc == 0u) { b.nloc = __builtin_amdgcn_readfirstlane(b.st[0]); b.nx = __builtin_amdgcn_readfirstlane(b.st[1]); }
}

struct UnitSync { XcdBarrier b; __device__ __forceinline__ void sync() const { XcdBarrier t = b; xcd_barrier(t); } };
#ifndef USYNC3
#define USYNC3 0
#endif
__global__ void __launch_bounds__(512, 2) hgswa_fwd(Args args) {
    extern __shared__ __attribute__((aligned(16))) unsigned char lds_raw[];
    LAS unsigned char* lds = (LAS unsigned char*)lds_raw;
    const int G = gridDim.x, c = blockIdx.x;
    unsigned char* ws = args.ws;
    const int lo = args.ph_lo, hi = args.ph_hi, sub = args.sub;
    float* SLAB = (float*)(ws + WS_SLAB);
    XcdBarrier xbar; xbar.bar = (unsigned*)(ws + WS_CTL); xbar.x = 0; xbar.st = (volatile LAS unsigned*)(lds + MISC_OFF); xbar.nloc = 0u; xbar.nx = 0u;
    if (args.sync) {
        if (threadIdx.x < 2) ((volatile LAS unsigned*)(lds + MISC_OFF))[threadIdx.x] = 0u;
        __syncthreads();
        xbar = xcd_barrier_post((unsigned*)(ws + WS_CTL), (volatile LAS unsigned*)(lds + MISC_OFF));
    }
    UnitSync usn; usn.b = xbar;
#define IN(k) (lo <= (k) && (k) < hi)
#define GRIDBAR() xcd_barrier(xbar)
#define SEAM(k) do { if (IN(k) && IN((k) + 1)) { GRIDBAR(); } } while (0)
    bf16_t* B0 = (bf16_t*)(ws + WS_B0); bf16_t* B1 = (bf16_t*)(ws + WS_B0 + BUFB); bf16_t* B2 = (bf16_t*)(ws + WS_B0 + 2 * BUFB); bf16_t* B3 = (bf16_t*)(ws + WS_B0 + 3 * BUFB);
    bf16_t* B4 = (bf16_t*)(ws + WS_B0 + 4 * BUFB); bf16_t* B5 = (bf16_t*)(ws + WS_B0 + 5 * BUFB);
    float* X1 = (float*)(ws + WS_X1); float* EBL = (float*)(ws + WS_EBL);
    bf16_t* K3 = (bf16_t*)(ws + WS_K3); bf16_t* V3 = (bf16_t*)(ws + WS_V3);
    unsigned long long* SSQ1 = (unsigned long long*)(ws + WS_SSQ1); unsigned long long* SSQ2 = (unsigned long long*)(ws + WS_SSQ2);
    const float* BT = (const float*)(ws + WS_BT);

    for (int rep_ = 0; rep_ < (PROBE_PHASE == 0 ? 2 : 1); ++rep_) { if (rep_) GRIDBAR();
    if (IN(0)) { p0_prep(args, G, lds); }
        }
    SEAM(0);
    for (int rep_ = 0; rep_ < (PROBE_PHASE == 1 ? 2 : 1); ++rep_) { if (rep_) GRIDBAR();
    if (IN(1)) {
        pg8::Gemm g{B0, (const bf16_t*)(ws + WS_W1), MP, N1, D, LDK}; pg8::TailOrder<4, 0, 0> S; S.init(MFULL, N1, G, c);
        EpiHg E{B1, B2, B3, B4, B5, EBL, (const float*)(ws + WS_RSTD0), (const float*)(ws + WS_LB)};
        if (sub != 2) pg8::gemm_phase<EpiHg, pg8::TailOrder<4, 0, 0>, true, PGSP2, UnitSync>(lds, g, S, E, SLAB, usn, false, 0);
        if (sub == 0) GRIDBAR();
        if (sub != 1) pg8::gemm_tail_fixup<4, EpiHg>(SLAB, N1 / 256, MFULL / 256, G, c, E);
    }
        }
    SEAM(1);
    for (int rep_ = 0; rep_ < ((PROBE_PHASE == 2 || PROBE_PHASE == 12 || PROBE_PHASE == 13) ? 2 : 1); ++rep_) { if (rep_) GRIDBAR();
    if (IN(2)) {
        if (G == 256) {
            if (c < 128) { if (!(rep_ == 1 && PROBE_PHASE == 13)) hg_prompt_unit(lds, c >> 5, c & 31, B1, B2, B3, B4, B5, EBL, B3, args.out + O_SP); }
            else if (!(rep_ == 1 && PROBE_PHASE == 12)) {
                for (int u = c - 128; u < NS * 32; u += 128) hg_sample_unit(lds, u >> 5, u & 31, B1, B2, B3, B4, B5, args.in[I_STATE], args.out + O_SS, B3);
                const int tid = opaque_tid(), wv = tid >> 6, ln = tid & 63; constexpr int CR = WC2 + WC3; LAS unsigned char* scr = lds + wv * WSCR;
                w_convert1(args, (c - 128) * 8 + wv, CR * 64, 1024, CR, WC1, ln, scr);
            }
        } else {
            for (int u = c; u < 128 + NS * 32; u += G) {
                if (u < 128) hg_prompt_unit(lds, u >> 5, u & 31, B1, B2, B3, B4, B5, EBL, B3, args.out + O_SP);
                else hg_sample_unit(lds, (u - 128) >> 5, (u - 128) & 31, B1, B2, B3, B4, B5, args.in[I_STATE], args.out + O_SS, B3);
            }
        }
    }
        }
    SEAM(2);
    if (IN(3)) {
        pg8::Gemm g{B3, (const bf16_t*)(ws + WS_W2), MP, N2, D, LDK}; pg8::TailOrder<16, 0, 0> S; S.init(MFULL, N2, G, c);
        EpiRes E{B0, B1, SSQ1};
        if (sub != 2) pg8::gemm_phase<EpiRes, pg8::TailOrder<16, 0, 0>, true, PGSP2, UnitSync>(lds, g, S, E, SLAB, usn, false, 0);
        if (sub == 0) GRIDBAR();
        if (sub != 1) pg8::gemm_tail_fixup<16, EpiRes>(SLAB, N2 / 256, MFULL / 256, G, c, E);
    }
    SEAM(3);
    for (int rep_ = 0; rep_ < ((PROBE_PHASE == 4 || (PROBE_PHASE >= 400 && PROBE_PHASE <= 405)) ? 2 : 1); ++rep_) { if (rep_) GRIDBAR();
    if (IN(4)) {
        pg8::Gemm g{B1, (const bf16_t*)(ws + WS_W3), MP, N3, D, LDK}; pg8::StaticOrder S; S.init(MP, N3, G, c);
        EpiSw E{B2, K3, V3, B3, SSQ1};
        if (rep_ == 0 || PROBE_PHASE == 4) pg8::gemm_phase<EpiSw, pg8::StaticOrder, true, PGSP2, UnitSync>(lds, g, S, E, nullptr, usn, (USYNC3 && args.sync), (MP / 256 * (N3 / 256) + G - 1) / G);
        else { EpiDummy ED{SLAB}; constexpr int AB = (PROBE_PHASE >= 400 && PROBE_PHASE <= 405) ? PROBE_PHASE - 400 : 0;
            pg8::gemm_phase<EpiDummy, pg8::StaticOrder, true, PGSP2, UnitSync, AB>(lds, g, S, ED, nullptr, usn, false, 0); }
        if (G == 256 && rep_ == 0) {
            constexpr int NU3 = (MP / 256) * (N3 / 256), NFULL = NU3 % 256, NIDLE = 256 - NFULL;
            if (c >= NFULL) { const int tid = opaque_tid(); w_convert(args, (c - NFULL) * 8 + (tid >> 6), WC4 * 64, NIDLE * 8, WC4, WC1 + WC2 + WC3, tid & 63, lds + (tid >> 6) * WSCR); }
        }
    }
        }
    SEAM(4);
    for (int rep_ = 0; rep_ < (PROBE_PHASE == 5 ? 2 : 1); ++rep_) { if (rep_) GRIDBAR();
    if (IN(5)) {
        {   float* okp = args.out + O_KP; float* ovp = args.out + O_VP; const int tid = opaque_tid();
            for (int i = c * 512 + tid; i < BATCH * 128 * 512; i += G * 512) { const int b = i >> 16, rr = (i >> 9) & 127, cc = i & 511; const size_t o = ((size_t)b * TP + (TP - 128) + rr) * 512 + cc; okp[i] = bf1(K3[o]); ovp[i] = bf1(V3[o]); } }
        constexpr int NQB = (TP + 31) / 32;
        {   const int GR = G >= 32 ? G / 32 : 1;
            for (int grp = c / GR; grp < BATCH * 8; grp += (G + GR - 1) / GR) {
                const int jr = c % GR, qlo = (NQB * jr) / GR, qhi = (NQB * (jr + 1)) / GR;
                attn_prompt_run(lds, grp >> 3, grp & 7, qlo, qhi, B2, K3, V3, B3, BT, args.in[I_SWSINK], B4);
            }
        }
        for (int v = c; v < NS * 8; v += G) attn_sample_unit(lds, v >> 3, v & 7, B2, K3, V3, B3, BT, args.in[I_SWSINK], args.in[I_CK], args.in[I_CV], args.out + O_KS, args.out + O_VS, B4);
    }
        }
    SEAM(5);
    if (IN(6)) {
        pg8::Gemm g{B4, (const bf16_t*)(ws + WS_W4), MP, N4, D, LDK}; pg8::TailOrder<16, 0, 0> S; S.init(MFULL, N4, G, c);
        EpiRes E{B1, B1, SSQ2};
        if (sub != 2) pg8::gemm_phase<EpiRes, pg8::TailOrder<16, 0, 0>, true, PGSP2, UnitSync>(lds, g, S, E, SLAB, usn, false, 0);
        if (sub == 0) GRIDBAR();
        if (sub != 1) pg8::gemm_tail_fixup<16, EpiRes>(SLAB, N4 / 256, MFULL / 256, G, c, E);
    }
    SEAM(6);
    for (int rep_ = 0; rep_ < (PROBE_PHASE == 7 ? 2 : 1); ++rep_) { if (rep_) GRIDBAR();
    if (IN(7)) {
        const int tid = opaque_tid(), lane = tid & 63, gw = c * 8 + (tid >> 6), NGW = G * 8; const float* fn = args.in[I_FNORM];
        for (int r = gw; r < MV; r += NGW) {
            float* dst;
            if (r < MPROMPT) { const int b = r / TP, t = r - b * TP; if (t < NMETA) continue; dst = args.out + O_YP + ((size_t)b * SEQ + (t - NMETA)) * D; }
            else dst = args.out + O_YS + (size_t)(r - MPROMPT) * D;
            const float rs = rstd_from_ssq(SSQ2[r]); const bf16_t* src = B1 + (size_t)r * LDK;
#pragma unroll
            for (int j = 0; j < 8; ++j) { const int o = j * 512 + lane * 8; const u32x4 xw = *(const u32x4*)(src + o); const f32x4 g0 = *(const f32x4*)(fn + o), g1 = *(const f32x4*)(fn + o + 4);
                const f32x4 x0 = {bf_lo(xw.x), bf_hi(xw.x), bf_lo(xw.y), bf_hi(xw.y)}, x1 = {bf_lo(xw.z), bf_hi(xw.z), bf_lo(xw.w), bf_hi(xw.w)};
                __builtin_nontemporal_store(x0 * rs * g0, (f32x4*)(dst + o)); __builtin_nontemporal_store(x1 * rs * g1, (f32x4*)(dst + o + 4)); }
        }
    }
    }
    #undef IN
#undef SEAM
#undef GRIDBAR
}

extern "C" void kernel_launch(void* const* d_in, const int* in_sizes, int n_in, void* d_out, int out_size, void* d_ws, size_t ws_size, hipStream_t stream) {
    static int grid = 0;
    if (grid == 0) {
        if (n_in != 17 || (size_t)out_size != O_END || ws_size < WS_END) { fprintf(stderr, "kernel_launch: unexpected shapes (n_in %d, out %d, ws %zu)\n", n_in, out_size, ws_size); grid = -1; return; }
        int dev = 0, cus = 0, per_cu = 0;
        if (hipGetDevice(&dev) != hipSuccess || hipDeviceGetAttribute(&cus, hipDeviceAttributeMultiprocessorCount, dev) != hipSuccess) { grid = -1; return; }
        if (hipFuncSetAttribute((const void*)hgswa_fwd, hipFuncAttributeMaxDynamicSharedMemorySize, LDS_BYTES) != hipSuccess) { fprintf(stderr, "kernel_launch: hipFuncSetAttribute failed\n"); grid = -1; return; }
        if (hipOccupancyMaxActiveBlocksPerMultiprocessor(&per_cu, (const void*)hgswa_fwd, 512, LDS_BYTES) != hipSuccess || per_cu < 1) { fprintf(stderr, "kernel_launch: occupancy query says %d blocks per CU\n", per_cu); grid = -1; (void)hipGetLastError(); return; }
        grid = cus;
    }
    if (grid < 0) return;
    (void)hipMemsetAsync((char*)d_ws + WS_CTL, 0, CTL_ZERO_BYTES, stream);
    Args a{};
    for (int i = 0; i < 17; ++i) a.in[i] = (const float*)d_in[i];
    a.out = (float*)d_out; a.ws = (unsigned char*)d_ws;
#if MK_N_LAUNCHES == 1
    a.ph_lo = 0; a.ph_hi = 8; a.sync = 1;
    void* kargs[] = {&a};
    hipError_t e = hipLaunchCooperativeKernel((const void*)hgswa_fwd, dim3(grid), dim3(512), kargs, LDS_BYTES, stream);
    if (e != hipSuccess) fprintf(stderr, "kernel_launch: cooperative launch failed: %s\n", hipGetErrorString(e));
#else
    for (int p = 0; p < 8; ++p) { a.ph_lo = p; a.ph_hi = p + 1; a.sync = 0;
        if (p == 1 || p == 3 || p == 6) { a.sub = 1; hipLaunchKernelGGL(hgswa_fwd, dim3(grid), dim3(512), LDS_BYTES, stream, a); a.sub = 2; hipLaunchKernelGGL(hgswa_fwd, dim3(grid), dim3(512), LDS_BYTES, stream, a); a.sub = 0; }
        else hipLaunchKernelGGL(hgswa_fwd, dim3(grid), dim3(512), LDS_BYTES, stream, a); }
#endif
}
```

```cpp
#include <hip/hip_runtime.h>
#include <hip/hip_cooperative_groups.h>
#include <cstdio>
#include <cstdint>
namespace cg = cooperative_groups;

#ifndef MK_N_LAUNCHES
#define MK_N_LAUNCHES 1
#endif

#ifndef PROBE_PHASE
#define PROBE_PHASE -1
#endif
#ifndef PGPRIO
#define PGPRIO 0
#endif
#ifndef PGSP4
#define PGSP4 true
#endif
#ifndef PGSP2
#define PGSP2 true
#endif
#define LAS __attribute__((address_space(3)))
typedef unsigned short bf16_t;
typedef short bf16x8 __attribute__((ext_vector_type(8)));
typedef short s16x4 __attribute__((ext_vector_type(4)));
typedef float f32x2 __attribute__((ext_vector_type(2)));
typedef float f32x4 __attribute__((ext_vector_type(4)));
typedef float f32x16 __attribute__((ext_vector_type(16)));
typedef unsigned u32x2 __attribute__((ext_vector_type(2)));
typedef unsigned u32x4 __attribute__((ext_vector_type(4)));
typedef __bf16 bf16x2_t __attribute__((ext_vector_type(2)));

constexpr int D = 4096, BATCH = 4, SEQ = 2048, NMETA = 16, TP = SEQ + NMETA  , MPROMPT = BATCH * TP  , NS = 32, MV = MPROMPT + NS  , MP = 8448  ;
constexpr int N1 = 16384, N2 = 4096, N3 = 9216, N4 = 4096;
constexpr int LDK = 4096;
constexpr int MFULL = 8192;
constexpr int NCHUNK = TP / 16;
constexpr int WIN = 128;
constexpr float EPS = 1e-6f;

constexpr size_t KiB = 1024, MiB = 1u << 20;
constexpr size_t WS_CTL = 0, WS_SSQ1 = 64 * KiB, WS_SSQ2 = 136 * KiB, CTL_ZERO_BYTES = 256 * KiB;
constexpr size_t WS_RSTD0 = 256 * KiB, WS_LB = 320 * KiB, WS_BT = 336 * KiB;
constexpr size_t WS_EBL = 1 * MiB, WS_K3 = 10 * MiB, WS_V3 = 19 * MiB;
constexpr size_t WS_W1 = 28 * MiB, WS_W2 = 158 * MiB, WS_W3 = 191 * MiB, WS_W4 = 265 * MiB;
constexpr size_t WS_X1 = 298 * MiB, WS_B0 = 430 * MiB, BUFB = 68 * MiB, WS_SLAB = WS_B0 + 6 * BUFB  , WS_END = WS_SLAB + 32 * MiB;
constexpr size_t O_YP = 0, O_YS = 33554432, O_SP = O_YS + 131072, O_KP = O_SP + 2097152, O_VP = O_KP + 262144, O_SS = O_VP + 262144, O_KS = O_SS + 16777216, O_VS = O_KS + 2097152, O_END = O_VS + 2097152;

constexpr int LDS_BYTES = PGSP4 ? 163840 : 147456;
constexpr int MISC_OFF = 135168;

__device__ __forceinline__ int opaque_tid() { int t = threadIdx.x; asm volatile("" : "+v"(t)); return t; }
__device__ __forceinline__ unsigned pk2(float lo, float hi) { f32x2 v = {lo, hi}; bf16x2_t b = __builtin_convertvector(v, bf16x2_t); return __builtin_bit_cast(unsigned, b); }
__device__ __forceinline__ float bf_lo(unsigned w) { return __uint_as_float(w << 16); }
__device__ __forceinline__ float bf_hi(unsigned w) { return __uint_as_float(w & 0xffff0000u); }
__device__ __forceinline__ float bf1(bf16_t x) { return __uint_as_float(((unsigned)x) << 16); }
__device__ __forceinline__ float fexp(float x) { return __expf(x); }
__device__ __forceinline__ float frcp(float x) { return __builtin_amdgcn_rcpf(x); }
__device__ __forceinline__ float silu_f(float x) { return x * frcp(1.0f + fexp(-x)); }
template <int CTRL> __device__ __forceinline__ float dpp_f(float v) { return __int_as_float(__builtin_amdgcn_update_dpp(0, __float_as_int(v), CTRL, 0xf, 0xf, true)); }
__device__ __forceinline__ float row_scan16(float x) { x += dpp_f<0x111>(x); x += dpp_f<0x112>(x); x += dpp_f<0x114>(x); x += dpp_f<0x118>(x); return x; }
__device__ __forceinline__ float row_sum16(float x) { x += dpp_f<0x128>(x); x += dpp_f<0x124>(x); x += dpp_f<0x122>(x); x += dpp_f<0x121>(x); return x; }
__host__ __device__ __forceinline__ int perm32(int rho) { const int n = rho >> 4, i = rho & 15; return 8 * (i >> 2) + 4 * n + (i & 3); }
__device__ __forceinline__ const float* x0_row(const float* xp, const float* xs, const float* meta, int r) {
    if (r < MPROMPT) { const int b = r / TP, t = r - b * TP; return t < NMETA ? meta + (size_t)t * D : xp + ((size_t)b * SEQ + (t - NMETA)) * D; }
    if (r < MV) return xs + (size_t)(r - MPROMPT) * D;
    return nullptr;
}
__device__ __forceinline__ size_t hm_off(int r, int rb, int h) {
    if (rb < MPROMPT) { const int b = rb / TP; return ((size_t)(b * 32 + h) * TP + (r - b * TP)) * 128; }
    return ((size_t)BATCH * 32 * TP + (size_t)(r - MPROMPT) * 32 + h) * 128;
}
__device__ __forceinline__ float rstd_from_ssq(unsigned long long s) { return rsqrtf((float)((double)s * (1.0 / 4294967296.0)) * (1.0f / D) + EPS); }
__device__ __forceinline__ void ssq_add(unsigned long long* p, float ss) { atomicAdd(p, (unsigned long long)((double)ss * 4294967296.0)); }

namespace pg8 {
constexpr int BM = 256, BK = 64, HALF = 128, HTB = HALF * BK * 2, STAGE_BYTES = 8 * HTB, NXCD = 8, WGM = 8;
__host__ __device__ __forceinline__ int lds_byte(int r, int c) { const int st = (r >> 4) * 2 + (c >> 5), rr = r & 15, cc = c & 31, ob = rr * 64 + cc * 2; return st * 1024 + (ob ^ (((ob >> 9) & 1) << 5)); }
__host__ __device__ __forceinline__ void stage_rc(int b, int& R, int& C) { const int st = b / 1024, sb = b % 1024, swz = sb ^ (((sb >> 9) & 1) << 5); R = (st >> 1) * 16 + swz / 64; C = (st & 1) * 32 + (swz % 64) / 2; }
struct Unit { int pm, pn, k0, nk, part; };
struct Gemm { const bf16_t* A; const bf16_t* Bt; int M, N, K, ld; };
struct StaticOrder {
    int nM, nN, nwg, G, c;
    __host__ __device__ __forceinline__ void init(int M, int N, int G_, int c_) { nM = M / BM; nN = N / BM; nwg = nM * nN; G = G_; c = c_; }
    __host__ __device__ __forceinline__ bool tile(int i, int& pm, int& pn) const {
        const long L = (long)i * G + c; if (L >= nwg) { pm = 0; pn = 0; return false; }
        int wgid = (int)L; { const int q = nwg / NXCD, r = nwg % NXCD, xcd = wgid % NXCD, off = wgid / NXCD; wgid = (xcd < r ? xcd * (q + 1) : r * (q + 1) + (xcd - r) * q) + off; }
        const int nig = WGM * nN, gid = wgid / nig, fm = gid * WGM, gsz = (nM - fm) < WGM ? (nM - fm) : WGM;
        pm = fm + ((wgid % nig) % gsz); pn = (wgid % nig) / gsz; return true;
    }
    __host__ __device__ __forceinline__ bool next(int i, Unit& u) const { int pm, pn; const bool ok = tile(i, pm, pn); u.pm = pm; u.pn = pn; u.k0 = 0; u.nk = 64; u.part = -1; return ok; }
};
template <int KS, int COFF, int GS> struct TailOrder {
    StaticOrder so; int nfull, NT, pmt;
    __host__ __device__ __forceinline__ void init(int Mfull, int N, int G_, int c_) { so.init(Mfull, N, G_, c_); nfull = c_ < so.nwg ? (so.nwg - c_ + G_ - 1) / G_ : 0; NT = so.nN * KS; pmt = Mfull / BM; }
    __host__ __device__ __forceinline__ bool next(int i, Unit& u) const {
        int pm, pn, k0 = 0, nk = 64, part = -1; bool ok;
        if (i < nfull) ok = so.tile(i, pm, pn);
        else {
            const int gs = GS ? GS : so.G; int tc = so.c - COFF; if (tc < 0) tc += so.G;
            const int s = tc + (i - nfull) * gs; ok = (tc < gs) && (s < NT);
            pm = pmt; pn = s / KS; nk = 64 / KS; k0 = (s - pn * KS) * nk; part = s;
        }
        u.pm = pm; u.pn = pn; u.k0 = k0; u.nk = nk; u.part = part; return ok;
    }
};
template <class Epi, class Sched, bool ALIGN_EPI, bool SP2, class Bar, int ABLATE = 0>
__device__ __forceinline__ void gemm_phase(LAS unsigned char* lds, const Gemm g, const Sched& S, const Epi& E, float* slab, const Bar ubar, bool usync, int urounds) {
    const int tid = opaque_tid(), wid = __builtin_amdgcn_readfirstlane(tid >> 6), lane = tid & 63, wr = wid >> 2, wc = wid & 3, fr = lane & 15, fq = lane >> 4;
    constexpr int ld = LDK;
    unsigned voff[2];
#pragma unroll
    for (int i = 0; i < 2; ++i) { int R, C; stage_rc(tid * 16 + i * 8192, R, C); voff[i] = (unsigned)(R * ld + C) * 2u; }
    const unsigned kstep = (unsigned)(BK * 2), hstep = (unsigned)(HALF * ld * 2), tstep = 2u * hstep;
    const __amdgpu_buffer_rsrc_t rA = __builtin_amdgcn_make_buffer_rsrc((void*)g.A, 0, ABLATE == 5 ? 0 : (int)((unsigned)g.M * (unsigned)ld * 2u), 0x00020000);
    const __amdgpu_buffer_rsrc_t rB = __builtin_amdgcn_make_buffer_rsrc((void*)g.Bt, 0, ABLATE == 5 ? 0 : (int)((unsigned)g.N * (unsigned)ld * 2u), 0x00020000);
    const unsigned ldsm0 = __builtin_amdgcn_readfirstlane((unsigned)(size_t)lds + (unsigned)wid * 1024u);
    const int aoff = lds_byte(wr * 64 + fr, fq * 8), boff = lds_byte(wc * 32 + fr, fq * 8);
#define PG8_SA(b, h) (((b) * 2 + (h)) * HTB)
#define PG8_SB(b, h) ((4 + (b) * 2 + (h)) * HTB)
#define PG8_STAGE(bufoff, rs, so) do { if (ABLATE == 3) break; _Pragma("unroll") for (int _i = 0; _i < 2; ++_i) \
        asm volatile("s_add_u32 m0, %0, %4\n\ts_nop 0\n\tbuffer_load_dwordx4 %1, %2, %3 offen lds" :: "s"(ldsm0), "v"(voff[_i]), "s"(rs), "s"(so), "n"((bufoff) + _i * 8192) : "m0", "scc", "memory"); } while (0)
#define PG8_LDA(dst, b, h) do { if (ABLATE == 2) break; _Pragma("unroll") for (int m = 0; m < 4; ++m) _Pragma("unroll") for (int k = 0; k < 2; ++k) dst[m][k] = *(const LAS bf16x8*)(lds + PG8_SA(b, h) + aoff + m * 2048 + k * 1024); } while (0)
#define PG8_LDB(dst, b, h) do { if (ABLATE == 2) break; _Pragma("unroll") for (int n = 0; n < 2; ++n) _Pragma("unroll") for (int k = 0; k < 2; ++k) dst[n][k] = *(const LAS bf16x8*)(lds + PG8_SB(b, h) + boff + n * 2048 + k * 1024); } while (0)
#define PG8_MMA(ai, bj, At, Bt) do { if (ABLATE == 1 && (ai) == 1) break; if (ABLATE == 4) break; if (PGPRIO == 1) __builtin_amdgcn_s_setprio(1); _Pragma("unroll") for (int m = 0; m < 4; ++m) _Pragma("unroll") for (int n = 0; n < 2; ++n) _Pragma("unroll") for (int k = 0; k < 2; ++k) \
        acc[ai][bj][m][n] = __builtin_amdgcn_mfma_f32_16x16x32_bf16(Bt[n][k], At[m][k], acc[ai][bj][m][n], 0, 0, 0); if (PGPRIO == 1) __builtin_amdgcn_s_setprio(0); } while (0)
#define PG8_WAIT_V(n) asm volatile("s_waitcnt vmcnt(" #n ")" ::: "memory")
#define PG8_WAIT_L(n) asm volatile("s_waitcnt lgkmcnt(" #n ")" ::: "memory")
#define PG8_BAR __builtin_amdgcn_s_barrier()
#define PG8_SCHED __builtin_amdgcn_sched_barrier(0)
    Unit cur, nxt; int ui = 0;
    if (!S.next(0, cur)) { if (usync) for (int r_ = 0; r_ < urounds; ++r_) ubar.sync(); return; }
    f32x4 acc[2][2][4][2];
#pragma unroll
    for (int a = 0; a < 2; ++a)
#pragma unroll
        for (int b = 0; b < 2; ++b)
#pragma unroll
            for (int m = 0; m < 4; ++m)
#pragma unroll
                for (int n = 0; n < 2; ++n) acc[a][b][m][n] = (f32x4){0.f, 0.f, 0.f, 0.f};
    bf16x8 At[4][2], B0[2][2], B1[2][2];
    unsigned cA = (unsigned)cur.pm * tstep + (unsigned)cur.k0 * kstep, cB = (unsigned)cur.pn * tstep + (unsigned)cur.k0 * kstep;
    if constexpr (PGSP4) {
    bf16x8 At1[4][2];
    const int oth = 1 - wr;
    const unsigned ldsm0A = __builtin_amdgcn_readfirstlane((unsigned)(size_t)lds + (unsigned)oth * 8192u + (unsigned)(wid & 3) * 2048u);
    unsigned vl; { int R, C; stage_rc(lane * 16, R, C); vl = (unsigned)(R * ld + C) * 2u; }
    const unsigned cwA = (unsigned)((oth * 4 + (wid & 3)) * 16) * (unsigned)(ld * 2), cwB = (unsigned)((wid >> 1) * 16) * (unsigned)(ld * 2) + (unsigned)(wid & 1) * 64u;
    cA += cwA; cB += cwB;
#define PG8_DMA2(m0base, imm, vo, rs, so, soimm) do { unsigned _t; asm volatile("s_add_u32 m0, %1, %5\n\ts_add_u32 %0, %4, %6\n\tbuffer_load_dwordx4 %2, %3, %0 offen lds" : "=&s"(_t) : "s"(m0base), "v"(vo), "s"(rs), "s"(so), "n"(imm), "n"(soimm) : "m0", "scc", "memory"); } while (0)
#define PG8_DAP(ma, h, i, pa) do { if (ABLATE != 3) PG8_DMA2(ma, (h) * HTB + (i) * 1024, vl, rA, (pa), (h) * (HALF * LDK * 2) + (i) * 64); } while (0)
#define PG8_DBR(mb, h, i, pb) do { if (ABLATE != 3) PG8_DMA2(mb, (h) * HTB + (i) * 8192, vl, rB, (pb), (h) * (HALF * LDK * 2) + (i) * (64 * LDK * 2)); } while (0)
#define PG8_STAGE_AP(abuf, pa) do { const unsigned _m = ldsm0A + (abuf), _p = (pa); PG8_DAP(_m, 0, 0, _p); PG8_DAP(_m, 0, 1, _p); PG8_DAP(_m, 1, 0, _p); PG8_DAP(_m, 1, 1, _p); } while (0)
#define PG8_STAGE_BR(slot, pb) do { const unsigned _m = ldsm0 + (slot), _p = (pb); PG8_DBR(_m, 0, 0, _p); PG8_DBR(_m, 0, 1, _p); PG8_DBR(_m, 1, 0, _p); PG8_DBR(_m, 1, 1, _p); } while (0)
#define PG8_LDBR(dst, bb, h) do { if (ABLATE == 2) break; _Pragma("unroll") for (int n = 0; n < 2; ++n) _Pragma("unroll") for (int k = 0; k < 2; ++k) dst[n][k] = *(const LAS bf16x8*)((bb) + (h) * HTB + n * 2048 + k * 1024); } while (0)
#define PG8_LOAD4(b, slot) do { const LAS unsigned char* _bb = lds + (slot) + boff; PG8_LDBR(B0, _bb, 0); PG8_LDBR(B1, _bb, 1); PG8_LDA(At, b, 0); PG8_LDA(At1, b, 1); } while (0)
#define PG8_PINB() asm volatile("" : "+v"(B0[0][0]), "+v"(B0[0][1]), "+v"(B0[1][0]), "+v"(B0[1][1]), "+v"(B1[0][0]), "+v"(B1[0][1]), "+v"(B1[1][0]), "+v"(B1[1][1]))
#define PG8_PINC1(a, b) asm volatile("" : "+v"(acc[a][b][0][0]), "+v"(acc[a][b][0][1]), "+v"(acc[a][b][1][0]), "+v"(acc[a][b][1][1]), "+v"(acc[a][b][2][0]), "+v"(acc[a][b][2][1]), "+v"(acc[a][b][3][0]), "+v"(acc[a][b][3][1]))
#define PG8_PINC() do { PG8_PINC1(0, 0); PG8_PINC1(0, 1); PG8_PINC1(1, 0); PG8_PINC1(1, 1); } while (0)
#define PG8_MMA4() do { PG8_PINB(); if (PGPRIO == 2) __builtin_amdgcn_s_setprio(1); PG8_MMA(0, 0, At, B0); PG8_MMA(0, 1, At, B1); PG8_MMA(1, 0, At1, B0); PG8_MMA(1, 1, At1, B1); if (PGPRIO == 2) __builtin_amdgcn_s_setprio(0); PG8_PINC(); } while (0)
    unsigned r0 = 4u * HTB, r1 = 6u * HTB, r2 = 8u * HTB;
    PG8_STAGE_AP(PG8_SA(0, 0), cA); if (wr == 1) PG8_STAGE_AP(PG8_SA(1, 0), cA + kstep); PG8_STAGE_BR(r0, cB); PG8_STAGE_BR(r1, cB + kstep);
    PG8_WAIT_V(0);
    PG8_BAR;
    if (wr == 1) PG8_BAR;
    for (;;) {
        const bool has_next = S.next(ui + 1, nxt);
        const unsigned nA = has_next ? (unsigned)nxt.pm * tstep + (unsigned)nxt.k0 * kstep + cwA : cA, nB = has_next ? (unsigned)nxt.pn * tstep + (unsigned)nxt.k0 * kstep + cwB : cB;
        int nt = cur.nk; asm volatile("" : "+s"(nt));
        __builtin_amdgcn_s_waitcnt(0x0F70);
        for (int t = 0; t < nt; t += 2) {
            const unsigned dA = (t + 2 < nt) ? cA + (unsigned)(t + 2) * kstep : nA + (unsigned)(t + 2 - nt) * kstep;
            const unsigned dB = (t + 2 < nt) ? cB + (unsigned)(t + 2) * kstep : nB + (unsigned)(t + 2 - nt) * kstep;
            PG8_LOAD4(0, r0);
            { const unsigned ab = wr ? (unsigned)PG8_SA(0, 0) : (unsigned)PG8_SA(1, 0), pa = wr ? dA : cA + (unsigned)(t + 1) * kstep; PG8_STAGE_AP(ab, pa); PG8_STAGE_BR(r2, dB); }
            PG8_WAIT_L(0); PG8_WAIT_V(8); PG8_BAR;
            PG8_MMA4(); PG8_BAR; PG8_SCHED;
            PG8_LOAD4(1, r1);
            { const unsigned ab = wr ? (unsigned)PG8_SA(1, 0) : (unsigned)PG8_SA(0, 0), pa = wr ? dA + kstep : dA; PG8_STAGE_AP(ab, pa); PG8_STAGE_BR(r0, dB + kstep); }
            PG8_WAIT_L(0); PG8_WAIT_V(8); PG8_BAR;
            PG8_MMA4(); PG8_BAR; PG8_SCHED;
            { const unsigned q = r0; r0 = r2; r2 = r1; r1 = q; }
        }
        if constexpr (ALIGN_EPI) { if (wr == 0) PG8_BAR; }
        const int tid2 = opaque_tid(), lane2 = tid2 & 63, wid2 = __builtin_amdgcn_readfirstlane(tid2 >> 6), wr2 = wid2 >> 2, wc2 = wid2 & 3, fr2 = lane2 & 15, fq2 = lane2 >> 4;
        if (cur.part >= 0) {
            float* sp = slab + ((size_t)cur.part * 16 * 512 + tid2) * 4;
#pragma unroll
            for (int bj = 0; bj < 2; ++bj)
#pragma unroll
                for (int m = 0; m < 4; ++m)
#pragma unroll
                    for (int n = 0; n < 2; ++n) *(f32x4*)(sp + (size_t)((bj * 4 + m) * 2 + n) * 512 * 4) = acc[0][bj][m][n];
        } else {
#pragma unroll
            for (int ai = 0; ai < 2; ++ai) {
                typename Epi::Pre pr[4];
#pragma unroll
                for (int m = 0; m < 4; ++m) pr[m] = E.pre(cur, ai, m, wr2, wc2, fr2, fq2);
#pragma unroll
                for (int m = 0; m < 4; ++m) { const f32x4 a4[2][2] = {{acc[ai][0][m][0], acc[ai][0][m][1]}, {acc[ai][1][m][0], acc[ai][1][m][1]}}; E.rows(a4, pr[m], cur, ai, m, wr2, wc2, fr2, fq2); }
            }
        }
        if (usync) ubar.sync();
        if (!has_next) break;
#pragma unroll
        for (int a = 0; a < 2; ++a)
#pragma unroll
            for (int b = 0; b < 2; ++b)
#pragma unroll
                for (int m = 0; m < 4; ++m)
#pragma unroll
                    for (int n = 0; n < 2; ++n) acc[a][b][m][n] = (f32x4){0.f, 0.f, 0.f, 0.f};
        cur = nxt; cA = nA; cB = nB; ++ui;
        if constexpr (ALIGN_EPI) { if (wr == 1) PG8_BAR; }
    }
    PG8_WAIT_V(0);
    if constexpr (!ALIGN_EPI) { if (wr == 0) PG8_BAR; }
    PG8_BAR;
    if (usync) for (int r_ = ui + 1; r_ < urounds; ++r_) ubar.sync();
#undef PG8_DMA2
#undef PG8_STAGE_AP
#undef PG8_STAGE_BR
#undef PG8_LDBR
#undef PG8_LOAD4
#undef PG8_MMA4
#undef PG8_PINB
#undef PG8_PINC1
#undef PG8_PINC
#undef PG8_DAP
#undef PG8_DBR
    } else {
    if constexpr (SP2) {
        PG8_STAGE(PG8_SB(0, 0), rB, cB); PG8_STAGE(PG8_SB(0, 1), rB, cB + hstep); PG8_STAGE(PG8_SA(0, 0), rA, cA); PG8_STAGE(PG8_SA(0, 1), rA, cA + hstep);
        if (wr == 1) PG8_BAR;
        PG8_WAIT_V(2); PG8_BAR;
        PG8_STAGE(PG8_SB(1, 0), rB, cB + kstep); PG8_STAGE(PG8_SA(1, 0), rA, cA + kstep); PG8_STAGE(PG8_SB(1, 1), rB, cB + hstep + kstep);
        PG8_WAIT_V(6); PG8_BAR;
    } else {
        PG8_STAGE(PG8_SB(0, 0), rB, cB); PG8_STAGE(PG8_SA(0, 0), rA, cA); PG8_STAGE(PG8_SB(0, 1), rB, cB + hstep); PG8_STAGE(PG8_SA(0, 1), rA, cA + hstep);
        if (wr == 1) PG8_BAR;
        PG8_WAIT_V(4); PG8_BAR;
        PG8_STAGE(PG8_SB(1, 0), rB, cB + kstep); PG8_STAGE(PG8_SA(1, 0), rA, cA + kstep); PG8_STAGE(PG8_SB(1, 1), rB, cB + hstep + kstep);
        PG8_WAIT_V(6); PG8_BAR;
    }
    for (;;) {
        const bool has_next = S.next(ui + 1, nxt);
        const unsigned nA = has_next ? (unsigned)nxt.pm * tstep + (unsigned)nxt.k0 * kstep : cA, nB = has_next ? (unsigned)nxt.pn * tstep + (unsigned)nxt.k0 * kstep : cB;
        const int nt = cur.nk;
        for (int t = 0; t < nt; t += 2) {
            const bool last = (t == nt - 2);
            const unsigned a1 = cA + (unsigned)(t + 1) * kstep;
            const unsigned a2 = last ? nA : cA + (unsigned)(t + 2) * kstep, b2 = last ? nB : cB + (unsigned)(t + 2) * kstep;
            const unsigned a3 = a2 + kstep, b3 = b2 + kstep;
            if constexpr (SP2) {
            PG8_LDB(B0, 0, 0); PG8_LDB(B1, 0, 1); PG8_SCHED; PG8_LDA(At, 0, 0); PG8_STAGE(PG8_SA(1, 1), rA, a1 + hstep);
            PG8_WAIT_V(8); PG8_WAIT_L(0); PG8_BAR; PG8_MMA(0, 0, At, B0); PG8_MMA(0, 1, At, B1); PG8_BAR; PG8_SCHED;
            PG8_LDA(At, 0, 1); PG8_STAGE(PG8_SB(0, 0), rB, b2); PG8_STAGE(PG8_SB(0, 1), rB, b2 + hstep); PG8_STAGE(PG8_SA(0, 0), rA, a2);
            PG8_WAIT_V(8); PG8_WAIT_L(0); PG8_BAR; PG8_MMA(1, 0, At, B0); PG8_MMA(1, 1, At, B1); PG8_BAR; PG8_SCHED;
            PG8_LDB(B0, 1, 0); PG8_LDB(B1, 1, 1); PG8_SCHED; PG8_LDA(At, 1, 0); PG8_STAGE(PG8_SA(0, 1), rA, a2 + hstep);
            PG8_WAIT_V(8); PG8_WAIT_L(0); PG8_BAR; PG8_MMA(0, 0, At, B0); PG8_MMA(0, 1, At, B1); PG8_BAR; PG8_SCHED;
            PG8_LDA(At, 1, 1); PG8_STAGE(PG8_SB(1, 0), rB, b3); PG8_STAGE(PG8_SB(1, 1), rB, b3 + hstep); PG8_STAGE(PG8_SA(1, 0), rA, a3);
            PG8_WAIT_V(8); PG8_WAIT_L(0); PG8_BAR; PG8_MMA(1, 0, At, B0); PG8_MMA(1, 1, At, B1); PG8_BAR; PG8_SCHED;
            } else {
            PG8_LDB(B0, 0, 0); PG8_SCHED; PG8_LDA(At, 0, 0); PG8_STAGE(PG8_SA(1, 1), rA, a1 + hstep);
            PG8_WAIT_L(8); PG8_BAR; PG8_WAIT_L(0); PG8_MMA(0, 0, At, B0); PG8_BAR; PG8_SCHED;
            PG8_LDB(B1, 0, 1); PG8_STAGE(PG8_SB(0, 0), rB, b2);
            PG8_BAR; PG8_WAIT_L(0); PG8_MMA(0, 1, At, B1); PG8_BAR;
            PG8_LDA(At, 0, 1); PG8_STAGE(PG8_SA(0, 0), rA, a2);
            PG8_BAR; PG8_WAIT_L(0); PG8_MMA(1, 0, At, B0); PG8_BAR; PG8_SCHED;
            PG8_STAGE(PG8_SB(0, 1), rB, b2 + hstep);
            PG8_WAIT_V(6); PG8_BAR; PG8_MMA(1, 1, At, B1); PG8_BAR;
            PG8_LDB(B0, 1, 0); PG8_SCHED; PG8_LDA(At, 1, 0); PG8_STAGE(PG8_SA(0, 1), rA, a2 + hstep);
            PG8_WAIT_L(8); PG8_BAR; PG8_WAIT_L(0); PG8_MMA(0, 0, At, B0); PG8_BAR; PG8_SCHED;
            PG8_LDB(B1, 1, 1); PG8_STAGE(PG8_SB(1, 0), rB, b3);
            PG8_BAR; PG8_WAIT_L(0); PG8_MMA(0, 1, At, B1); PG8_BAR;
            PG8_LDA(At, 1, 1); PG8_STAGE(PG8_SA(1, 0), rA, a3);
            PG8_BAR; PG8_WAIT_L(0); PG8_MMA(1, 0, At, B0); PG8_BAR; PG8_SCHED;
            PG8_STAGE(PG8_SB(1, 1), rB, b3 + hstep);
            PG8_WAIT_V(6); PG8_BAR; PG8_MMA(1, 1, At, B1); PG8_BAR;
            }
        }
        if constexpr (ALIGN_EPI) { if (wr == 0) PG8_BAR; }
        const int tid2 = opaque_tid(), lane2 = tid2 & 63, wid2 = __builtin_amdgcn_readfirstlane(tid2 >> 6), wr2 = wid2 >> 2, wc2 = wid2 & 3, fr2 = lane2 & 15, fq2 = lane2 >> 4;
        if (cur.part >= 0) {
            float* sp = slab + ((size_t)cur.part * 16 * 512 + tid2) * 4;
#pragma unroll
            for (int bj = 0; bj < 2; ++bj)
#pragma unroll
                for (int m = 0; m < 4; ++m)
#pragma unroll
                    for (int n = 0; n < 2; ++n) *(f32x4*)(sp + (size_t)((bj * 4 + m) * 2 + n) * 512 * 4) = acc[0][bj][m][n];
        } else {
#pragma unroll
            for (int ai = 0; ai < 2; ++ai) {
                typename Epi::Pre pr[4];
#pragma unroll
                for (int m = 0; m < 4; ++m) pr[m] = E.pre(cur, ai, m, wr2, wc2, fr2, fq2);
#pragma unroll
                for (int m = 0; m < 4; ++m) { const f32x4 a4[2][2] = {{acc[ai][0][m][0], acc[ai][0][m][1]}, {acc[ai][1][m][0], acc[ai][1][m][1]}}; E.rows(a4, pr[m], cur, ai, m, wr2, wc2, fr2, fq2); }
            }
        }
        if (usync) ubar.sync();
        if (!has_next) break;
#pragma unroll
        for (int a = 0; a < 2; ++a)
#pragma unroll
            for (int b = 0; b < 2; ++b)
#pragma unroll
                for (int m = 0; m < 4; ++m)
#pragma unroll
                    for (int n = 0; n < 2; ++n) acc[a][b][m][n] = (f32x4){0.f, 0.f, 0.f, 0.f};
        cur = nxt; cA = nA; cB = nB; ++ui;
        if constexpr (ALIGN_EPI) { if (wr == 1) PG8_BAR; }
    }
    PG8_WAIT_V(0);
    if constexpr (!ALIGN_EPI) { if (wr == 0) PG8_BAR; }
    PG8_BAR;
    if (usync) for (int r_ = ui + 1; r_ < urounds; ++r_) ubar.sync();
    }
#undef PG8_SA
#undef PG8_SB
#undef PG8_STAGE
#undef PG8_LDA
#undef PG8_LDB
#undef PG8_MMA
#undef PG8_WAIT_V
#undef PG8_WAIT_L
#undef PG8_BAR
#undef PG8_SCHED
}
template <int KS, class Epi> __device__ __forceinline__ void gemm_tail_fixup(const float* slab, int nN, int pmt, int G, int c, const Epi& E) {
    const int tid = opaque_tid(), wid = __builtin_amdgcn_readfirstlane(tid >> 6), lane = tid & 63, wr = wid >> 2, wc = wid & 3, fr = lane & 15, fq = lane >> 4;
    for (int pc = c; pc < nN * 4; pc += G) {
        const int pn = pc >> 2, m = pc & 3;
        f32x4 t[2][2];
#pragma unroll
        for (int bj = 0; bj < 2; ++bj)
#pragma unroll
            for (int n = 0; n < 2; ++n) t[bj][n] = (f32x4){0.f, 0.f, 0.f, 0.f};
#pragma unroll 4
        for (int ks = 0; ks < KS; ++ks) {
            const float* sp = slab + ((size_t)(pn * KS + ks) * 16 * 512 + tid) * 4;
#pragma unroll
            for (int bj = 0; bj < 2; ++bj)
#pragma unroll
                for (int n = 0; n < 2; ++n) t[bj][n] += *(const f32x4*)(sp + (size_t)((bj * 4 + m) * 2 + n) * 512 * 4);
        }
        Unit u; u.pm = pmt; u.pn = pn; u.k0 = 0; u.nk = 64; u.part = -1;
        E.rows(t, E.pre(u, 0, m, wr, wc, fr, fq), u, 0, m, wr, wc, fr, fq);
    }
}
}

typedef const f32x4 (&Acc4)[2][2];
__device__ __forceinline__ u32x4 pack8(const f32x4& a, const f32x4& b) { u32x4 w; w.x = pk2(a[0], a[1]); w.y = pk2(a[2], a[3]); w.z = pk2(b[0], b[1]); w.w = pk2(b[2], b[3]); return w; }

struct EpiHg {
    bf16_t *QT, *KT, *KD, *V, *SG; float* EBL; const float* RSTD0; const float* LB;
    struct Pre { float rs; };
    __device__ __forceinline__ Pre pre(const pg8::Unit& u, int ai, int m, int wr, int wc, int fr, int fq) const { Pre p; p.rs = RSTD0[u.pm * 256 + ai * 128 + wr * 64 + m * 16 + fr]; return p; }
    __device__ __forceinline__ void rows(Acc4 a, const Pre& pr, const pg8::Unit& u, int ai, int m, int wr, int wc, int fr, int fq) const {
        const int pn = u.pn, r = u.pm * 256 + ai * 128 + wr * 64 + m * 16 + fr; const float rs = pr.rs;
        if (pn < 32) {
            const int col = pn * 128 + wc * 32 + 8 * fq;
            const f32x4 l0 = *(const f32x4*)(LB + col), l1 = *(const f32x4*)(LB + col + 4);
            const float lbv[8] = {l0[0], l0[1], l0[2], l0[3], l1[0], l1[1], l1[2], l1[3]};
            const bool prompt = (r - fr) < MPROMPT;
            float qo[8], ko[8], eb8[8], lg[8];
#pragma unroll
            for (int n = 0; n < 2; ++n)
#pragma unroll
                for (int j = 0; j < 4; ++j) {
                    const int ix = 4 * n + j;
                    const float q = a[0][n][j] * rs; float f = a[1][n][j] * rs;
                    f = fminf(fmaxf(f, -60.f), 60.f);
                    const float e = fexp(-f), sig = frcp(1.0f + e), oms = e * sig, oml = 1.0f - lbv[ix];
                    const float fg = lbv[ix] + oml * sig;
                    qo[ix] = silu_f(q); ko[ix] = oml * oms; lg[ix] = fg; eb8[ix] = 0.f;
                }
            if (prompt) {
#pragma unroll
                for (int ix = 0; ix < 8; ++ix) lg[ix] = __builtin_amdgcn_logf(lg[ix]);
#pragma unroll
                for (int ix = 0; ix < 8; ++ix) lg[ix] += dpp_f<0x111>(lg[ix]);
#pragma unroll
                for (int ix = 0; ix < 8; ++ix) lg[ix] += dpp_f<0x112>(lg[ix]);
#pragma unroll
                for (int ix = 0; ix < 8; ++ix) lg[ix] += dpp_f<0x114>(lg[ix]);
#pragma unroll
                for (int ix = 0; ix < 8; ++ix) lg[ix] += dpp_f<0x118>(lg[ix]);
#pragma unroll
                for (int ix = 0; ix < 8; ++ix) { const float ebc = __builtin_amdgcn_exp2f(lg[ix]), ieb = __builtin_amdgcn_exp2f(-lg[ix]);
                    qo[ix] *= ebc; ko[ix] *= ieb; eb8[ix] = ebc; }
            }
            const size_t o = hm_off(r, r - fr, pn) + wc * 32 + 8 * fq;
            u32x4 w; w.x = pk2(qo[0], qo[1]); w.y = pk2(qo[2], qo[3]); w.z = pk2(qo[4], qo[5]); w.w = pk2(qo[6], qo[7]); __builtin_nontemporal_store(w, (u32x4*)(QT + o));
            w.x = pk2(ko[0], ko[1]); w.y = pk2(ko[2], ko[3]); w.z = pk2(ko[4], ko[5]); w.w = pk2(ko[6], ko[7]); __builtin_nontemporal_store(w, (u32x4*)(KT + o));
            if (prompt && fr == 15) { const int b = r / TP; float* ep = EBL + ((size_t)(b * 32 + pn) * NCHUNK + ((r - b * TP) >> 4)) * 128 + wc * 32 + 8 * fq; *(f32x4*)ep = (f32x4){eb8[0], eb8[1], eb8[2], eb8[3]}; *(f32x4*)(ep + 4) = (f32x4){eb8[4], eb8[5], eb8[6], eb8[7]}; }
        } else {
            const bool isg = pn >= 48; bf16_t* dst = isg ? SG : V;
            const int h0 = (pn - (isg ? 48 : 32)) * 2;
#pragma unroll
            for (int bj = 0; bj < 2; ++bj) {
                f32x4 v0 = a[bj][0] * rs, v1 = a[bj][1] * rs;
                if (isg) {
#pragma unroll
                    for (int j = 0; j < 4; ++j) { v0[j] = silu_f(v0[j]); v1[j] = silu_f(v1[j]); } }
                __builtin_nontemporal_store(pack8(v0, v1), (u32x4*)(dst + hm_off(r, r - fr, h0 + bj) + wc * 32 + 8 * fq));
            }
        }
    }
};
struct EpiRes {
    const bf16_t* XI; bf16_t* XO; unsigned long long* SSQ;
    struct Pre { u32x4 x[2]; };
    __device__ __forceinline__ Pre pre(const pg8::Unit& u, int ai, int m, int wr, int wc, int fr, int fq) const {
        const int col0 = u.pn * 256 + wc * 32 + 8 * fq, r = u.pm * 256 + ai * 128 + wr * 64 + m * 16 + fr; Pre p;
#pragma unroll
        for (int bj = 0; bj < 2; ++bj) p.x[bj] = *(const u32x4*)(XI + (size_t)r * LDK + col0 + bj * 128);
        return p; }
    __device__ __forceinline__ void rows(Acc4 a, const Pre& pr, const pg8::Unit& u, int ai, int m, int wr, int wc, int fr, int fq) const {
        const int col0 = u.pn * 256 + wc * 32 + 8 * fq, r = u.pm * 256 + ai * 128 + wr * 64 + m * 16 + fr;
        float ss = 0.f;
#pragma unroll
        for (int bj = 0; bj < 2; ++bj) {
            const size_t o = (size_t)r * LDK + col0 + bj * 128;
            const u32x4 xw = pr.x[bj];
            const f32x4 a0 = {bf_lo(xw.x), bf_hi(xw.x), bf_lo(xw.y), bf_hi(xw.y)}, a1 = {bf_lo(xw.z), bf_hi(xw.z), bf_lo(xw.w), bf_hi(xw.w)};
            const f32x4 v0 = a[bj][0] + a0, v1 = a[bj][1] + a1;
            *(u32x4*)(XO + o) = pack8(v0, v1);
            ss += (v0[0] * v0[0] + v0[1] * v0[1]) + (v0[2] * v0[2] + v0[3] * v0[3]) + (v1[0] * v1[0] + v1[1] * v1[1]) + (v1[2] * v1[2] + v1[3] * v1[3]);
        }
        ss += __shfl_xor(ss, 16); ss += __shfl_xor(ss, 32);
        if (fq == 0) ssq_add(SSQ + r, ss);
    }
};
struct EpiSw {
    bf16_t *Q3, *K3, *V3, *SG3; const unsigned long long* SSQ;
    struct Pre { unsigned long long s; };
    __device__ __forceinline__ Pre pre(const pg8::Unit& u, int ai, int m, int wr, int wc, int fr, int fq) const { Pre p; p.s = SSQ[u.pm * 256 + ai * 128 + wr * 64 + m * 16 + fr]; return p; }
    __device__ __forceinline__ void rows(Acc4 a, const Pre& pr, const pg8::Unit& u, int ai, int m, int wr, int wc, int fr, int fq) const {
        const int pn = u.pn; bf16_t* dst; int ld, colt; float sc = 1.f; bool act = false;
        if (pn < 16) { dst = Q3; ld = D; colt = pn * 256; sc = 0.125f * 1.4426950408889634f; }
        else if (pn < 18) { dst = K3; ld = 512; colt = (pn - 16) * 256; }
        else if (pn < 20) { dst = V3; ld = 512; colt = (pn - 18) * 256; }
        else { dst = SG3; ld = D; colt = (pn - 20) * 256; act = true; }
        const int col0 = colt + wc * 32 + 8 * fq, r = u.pm * 256 + ai * 128 + wr * 64 + m * 16 + fr; const float rs = rstd_from_ssq(pr.s) * sc;
#pragma unroll
        for (int bj = 0; bj < 2; ++bj) {
            f32x4 v0 = a[bj][0] * rs, v1 = a[bj][1] * rs;
            if (act) {
#pragma unroll
                for (int j = 0; j < 4; ++j) { v0[j] = silu_f(v0[j]); v1[j] = silu_f(v1[j]); } }
            if (pn >= 16 && pn < 20) *(u32x4*)(dst + (size_t)r * ld + col0 + bj * 128) = pack8(v0, v1);
            else *(u32x4*)(dst + (size_t)r * ld + col0 + bj * 128) = pack8(v0, v1);
        }
    }
};

struct EpiDummy { float* out;
    struct Pre { int z; };
    __device__ __forceinline__ Pre pre(const pg8::Unit& u, int ai, int m, int wr, int wc, int fr, int fq) const { Pre p; p.z = 0; return p; }
    __device__ __forceinline__ void rows(Acc4 a, const Pre& pr, const pg8::Unit& u, int ai, int m, int wr, int wc, int fr, int fq) const {
        *(f32x4*)(out + ((size_t)(blockIdx.x * 512 + threadIdx.x) * 8 + ai * 4 + m) * 4) = (a[0][0] + a[0][1]) + (a[1][0] + a[1][1]); }
};
struct Args { const float* in[17]; float* out; unsigned char* ws; int ph_lo, ph_hi, sync, sub; };
enum { I_XP = 0, I_XS, I_STATE, I_CK, I_CV, I_META, I_RELB, I_HGLB, I_HGNORM, I_HGWIN, I_HGONORM, I_HGWOUT, I_SWNORM, I_SWWIN, I_SWSINK, I_SWWOUT, I_FNORM };

constexpr int WSCR = 64 * 132;
__device__ __forceinline__ float wave_sum(float v) {
#pragma unroll
    for (int o = 1; o < 64; o <<= 1) v += __shfl_xor(v, o);
    return v;
}
struct WItem { const float* src; const float* scl; bf16_t* dst; int N; bool nt; };
constexpr int WC1 = N1 / 64, WC2 = N2 / 64, WC3 = N3 / 64, WC4 = N4 / 64, WCT = WC1 + WC2 + WC3 + WC4;
__device__ __forceinline__ WItem w_resolve(const Args& a, int cb, int kb, int lane) {
    unsigned char* ws = a.ws; const float* W; const float* scale; bf16_t* Wt; int N; bool qf = false, late = false;
    if (cb < WC1) { W = a.in[I_HGWIN]; N = N1; Wt = (bf16_t*)(ws + WS_W1); scale = a.in[I_HGNORM]; qf = true; }
    else if (cb < WC1 + WC2) { cb -= WC1; W = a.in[I_HGWOUT]; N = N2; Wt = (bf16_t*)(ws + WS_W2); scale = a.in[I_HGONORM]; }
    else if (cb < WC1 + WC2 + WC3) { cb -= WC1 + WC2; W = a.in[I_SWWIN]; N = N3; Wt = (bf16_t*)(ws + WS_W3); scale = a.in[I_SWNORM]; late = true; }
    else { cb -= WC1 + WC2 + WC3; W = a.in[I_SWWOUT]; N = N4; Wt = (bf16_t*)(ws + WS_W4); scale = nullptr; late = true; }
    const int ocb = cb * 64; int lcb = ocb;
    if (qf && ocb < 8192) lcb = ((ocb >> 7) & 31) * 256 + (ocb >> 12) * 128 + (ocb & 127);
    const int cgp = lane & 15, kq = lane >> 4;
    WItem it; it.N = N; it.nt = late;
    it.src = W + (size_t)(kb * 64 + 2 * kq) * N + ocb + 4 * cgp;
    it.scl = scale ? scale + kb * 64 + 2 * kq : nullptr;
    it.dst = Wt + (size_t)lcb * LDK + kb * 64 + 8 * (lane & 7);
    return it;
}
__device__ __forceinline__ void w_load(const WItem& it, f32x4 (&v)[16], f32x2 (&sc)[8]) {
#pragma unroll
    for (int i = 0; i < 8; ++i) sc[i] = it.scl ? *(const f32x2*)(it.scl + 8 * i) : (f32x2){1.f, 1.f};
#pragma unroll
    for (int i = 0; i < 8; ++i) { v[2 * i] = __builtin_nontemporal_load((const f32x4*)(it.src + (size_t)(8 * i) * it.N)); v[2 * i + 1] = __builtin_nontemporal_load((const f32x4*)(it.src + (size_t)(8 * i + 1) * it.N)); }
}
__device__ __forceinline__ void w_finish(const WItem& it, const f32x4 (&v)[16], const f32x2 (&sc)[8], int lane, LAS unsigned char* scr) {
    const int cgp = lane & 15, kq = lane >> 4;
#pragma unroll
    for (int i = 0; i < 8; ++i) {
#pragma unroll
        for (int jj = 0; jj < 4; ++jj) *(LAS unsigned*)(scr + (4 * cgp + jj) * 132 + (8 * i + 2 * kq) * 2) = pk2(v[2 * i][jj] * sc[i].x, v[2 * i + 1][jj] * sc[i].y);
    }
#pragma unroll
    for (int j = 0; j < 8; ++j) {
        const int rr = (lane >> 3) + 8 * j, c = (rr & ~31) + perm32(rr & 31);
        LAS unsigned char* p = scr + c * 132 + (lane & 7) * 16;
        u32x4 w; w.x = *(LAS unsigned*)p; w.y = *(LAS unsigned*)(p + 4); w.z = *(LAS unsigned*)(p + 8); w.w = *(LAS unsigned*)(p + 12);
        if (it.nt) __builtin_nontemporal_store(w, (u32x4*)(it.dst + (size_t)rr * LDK)); else *(u32x4*)(it.dst + (size_t)rr * LDK) = w;
    }
}
__device__ __forceinline__ void w_convert1(const Args& a, int first, int end, int step, int ncb, int cb0, int lane, LAS unsigned char* scr) {
    for (int it = first; it < end; it += step) {
        f32x4 va[16]; f32x2 sa[8];
        const int kba = it / ncb; const WItem A = w_resolve(a, cb0 + (it - kba * ncb), kba, lane);
        w_load(A, va, sa); w_finish(A, va, sa, lane, scr);
    }
}
__device__ __forceinline__ void w_convert(const Args& a, int first, int end, int step, int ncb, int cb0, int lane, LAS unsigned char* scr) {
    for (int it = first; it < end; it += 2 * step) {
        f32x4 va[16], vb[16]; f32x2 sa[8], sb[8];
        const int kba = it / ncb; const WItem A = w_resolve(a, cb0 + (it - kba * ncb), kba, lane);
        w_load(A, va, sa);
        const int it2 = it + step; const bool hasB = it2 < end;
        const int kbb = hasB ? it2 / ncb : kba; const WItem B = w_resolve(a, cb0 + (hasB ? it2 - kbb * ncb : it - kba * ncb), kbb, lane);
        if (hasB) w_load(B, vb, sb);
        w_finish(A, va, sa, lane, scr);
        if (hasB) w_finish(B, vb, sb, lane, scr);
    }
}
__device__ __forceinline__ void p0_prep(const Args& a, int G, LAS unsigned char* lds) {
    const int tid = opaque_tid(), lane = tid & 63, wave = tid >> 6;
    const int gw = blockIdx.x * 8 + wave, NGW = G * 8;
    unsigned char* ws = a.ws;
    {   const int CT = (G == 256) ? WC1 : WCT;
        LAS unsigned char* scr = lds + wave * WSCR;
        w_convert(a, gw, CT * 64, NGW, CT, 0, lane, scr);
    }
    bf16_t* XB0 = (bf16_t*)(ws + WS_B0); float* RSTD0 = (float*)(ws + WS_RSTD0);
    {   const int r0 = gw, rstep = NGW;
        for (int r = r0; r < MP; r += rstep) {
            const float* src = x0_row(a.in[I_XP], a.in[I_XS], a.in[I_META], r);
            bf16_t* dst = XB0 + (size_t)r * LDK;
            if (!src) { for (int j = 0; j < 8; ++j) *(u32x4*)(dst + j * 512 + lane * 8) = (u32x4){0u, 0u, 0u, 0u}; if (lane == 0) RSTD0[r] = 0.f; continue; }
            float ss = 0.f;
#pragma unroll
            for (int j = 0; j < 8; ++j) {
                const f32x4 v0 = __builtin_nontemporal_load((const f32x4*)(src + j * 512 + lane * 8)), v1 = __builtin_nontemporal_load((const f32x4*)(src + j * 512 + lane * 8 + 4));
                ss += (v0[0] * v0[0] + v0[1] * v0[1]) + (v0[2] * v0[2] + v0[3] * v0[3]) + (v1[0] * v1[0] + v1[1] * v1[1]) + (v1[2] * v1[2] + v1[3] * v1[3]);
                *(u32x4*)(dst + j * 512 + lane * 8) = pack8(v0, v1);
            }
            ss = wave_sum(ss);
            if (lane == 0) RSTD0[r] = rsqrtf(ss * (1.0f / D) + EPS);
        }
    }
    const int gt = blockIdx.x * 512 + tid, NGT = G * 512;
    float* LB = (float*)(ws + WS_LB); float* BT = (float*)(ws + WS_BT);
    for (int i = gt; i < D; i += NGT) {
        const float x0 = a.in[I_HGLB][i], x1 = a.in[I_HGLB][D + i], x2 = a.in[I_HGLB][2 * D + i];
        const float mx = fmaxf(x0, fmaxf(x1, x2)); const float e0 = expf(x0 - mx), e1 = expf(x1 - mx), e2 = expf(x2 - mx);
        LB[i] = e0 / (e0 + e1 + e2);
    }
    for (int i = gt; i < 64 * 129; i += NGT) {
        const int h = i / 129, dist = i - h * 129; int bucket;
        if (dist < 16) bucket = dist;
        else { const float dd = (float)dist; int large = 16 + (int)(logf(dd / 16.0f) / 2.0794415416798357f * 16.0f); bucket = large < 31 ? large : 31; }
        BT[h * 132 + dist] = a.in[I_RELB][bucket * 64 + h] * 1.4426950408889634f;
    }
}

__device__ __forceinline__ s16x4 ds_tr16(LAS unsigned char* p) { return __builtin_bit_cast(s16x4, __builtin_amdgcn_ds_read_tr16_b64_v4i16((LAS s16x4*)p)); }
__device__ __forceinline__ bf16x8 mk8(u32x2 lo, u32x2 hi) { u32x4 w = {lo.x, lo.y, hi.x, hi.y}; return __builtin_bit_cast(bf16x8, w); }
__device__ __forceinline__ bf16x8 mk8z(s16x4 t) { bf16x8 r = {t[0], t[1], t[2], t[3], 0, 0, 0, 0}; return r; }

struct HgRegs { u32x2 q0, k0, v0, sg0, q1, k1, v1, sg1; f32x4 e0, e1; };
struct HgCtx { const char *QT, *KT, *V, *SG, *EB; char* A2; unsigned toff, eoff, aoff; int tid, w, lv, g, srow, sseg; };
constexpr int HG_NSTEP = (NCHUNK + 1) / 2;
constexpr int HG_RS = 272, HG_RN = 288, HG_TILE = 16 * HG_RN;
constexpr int HG_BUF = 10 * HG_TILE + 512, HG_OB_OFF = 2 * HG_BUF, HG_OROW = 132 * 4, HG_OBUF = 32 * HG_OROW, HG_SQ_OFF = HG_OB_OFF + 2 * HG_OBUF;
static_assert(HG_SQ_OFF + 2 * 32 * 8 * 4 <= MISC_OFF, "recurrence LDS map");
__device__ __forceinline__ u32x2 scale4(u32x2 w, const f32x4& e) { u32x2 r; r.x = pk2(bf_lo(w.x) * e[0], bf_hi(w.x) * e[1]); r.y = pk2(bf_lo(w.y) * e[2], bf_hi(w.y) * e[3]); return r; }
__device__ __forceinline__ void hg_load(HgRegs& r, const HgCtx& x, int p) {
    const size_t cs = (size_t)p * (32 * 128 * 2);
    const bool has1 = 2 * p + 1 < NCHUNK;
    const size_t c1 = cs + (has1 ? 16 * 128 * 2 : 0), ce = (size_t)p * (2 * 128 * 4), ce1 = ce + (has1 ? 128 * 4 : 0);
    r.q0 = *(const u32x2*)(x.QT + cs + x.toff); r.k0 = *(const u32x2*)(x.KT + cs + x.toff); r.v0 = *(const u32x2*)(x.V + cs + x.toff); r.sg0 = *(const u32x2*)(x.SG + cs + x.toff);
    r.e0 = *(const f32x4*)(x.EB + ce + x.eoff);
    r.q1 = *(const u32x2*)(x.QT + c1 + x.toff); r.k1 = *(const u32x2*)(x.KT + c1 + x.toff); r.v1 = *(const u32x2*)(x.V + c1 + x.toff); r.sg1 = *(const u32x2*)(x.SG + c1 + x.toff);
    r.e1 = *(const f32x4*)(x.EB + ce1 + x.eoff);
}
__device__ __forceinline__ void hg_fix_last(HgRegs& r, int p) {
    if (2 * p + 1 >= NCHUNK) { const u32x2 z = {0u, 0u}; r.q1 = z; r.k1 = z; r.v1 = z; r.e1 = (f32x4){1.f, 1.f, 1.f, 1.f}; }
}
__device__ __forceinline__ void hg_store(const HgRegs& r, const HgCtx& x, LAS unsigned char* lds, int bi) {
    LAS unsigned char* bn = lds + bi * HG_BUF + x.srow * HG_RN + x.sseg * 8;
    LAS unsigned char* bp = lds + bi * HG_BUF + x.srow * HG_RS + (32 * (x.sseg >> 3) + 8 * (x.sseg & 3) + 4 * ((x.sseg >> 2) & 1)) * 2;
    const f32x4 e01 = r.e0 * r.e1;
    *(LAS u32x2*)(bp) = r.q0; *(LAS u32x2*)(bp + HG_TILE) = r.k0; *(LAS u32x2*)(bn + 3 * HG_TILE) = r.v0;
    *(LAS u32x2*)(bp + 4 * HG_TILE) = r.q1; *(LAS u32x2*)(bp + 5 * HG_TILE) = r.k1; *(LAS u32x2*)(bn + 6 * HG_TILE) = scale4(r.k1, r.e1); *(LAS u32x2*)(bn + 7 * HG_TILE) = r.v1;
    *(LAS u32x2*)(bp + 8 * HG_TILE) = scale4(r.q1, r.e0); *(LAS u32x2*)(bn + 9 * HG_TILE) = scale4(r.k0, e01);
    if (x.srow == 0) *(LAS f32x4*)(lds + bi * HG_BUF + 10 * HG_TILE + x.sseg * 16) = e01;
}
__device__ __forceinline__ void hg_frags(bf16x8 (&f)[4], LAS unsigned char* tile, int lv, int g) {
#pragma unroll
    for (int p = 0; p < 4; ++p) f[p] = *(LAS bf16x8*)(tile + lv * HG_RS + (32 * p + 8 * g) * 2);
}
__device__ __forceinline__ f32x4 hg_dot4(const bf16x8 (&a)[4], const bf16x8 (&b)[4]) {
    f32x4 x = {0.f, 0.f, 0.f, 0.f}, y = {0.f, 0.f, 0.f, 0.f};
    x = __builtin_amdgcn_mfma_f32_16x16x32_bf16(a[0], b[0], x, 0, 0, 0); y = __builtin_amdgcn_mfma_f32_16x16x32_bf16(a[1], b[1], y, 0, 0, 0);
    x = __builtin_amdgcn_mfma_f32_16x16x32_bf16(a[2], b[2], x, 0, 0, 0); y = __builtin_amdgcn_mfma_f32_16x16x32_bf16(a[3], b[3], y, 0, 0, 0);
    return x + y;
}
__device__ __forceinline__ void hg_step(f32x4 (&S)[8], HgRegs& RL, HgRegs& RS, u32x2& sgc0, u32x2& sgc1, const HgCtx& x, LAS unsigned char* lds, int p) {
    const int cb = p & 1, w = x.w, lv = x.lv, g = x.g;
    hg_load(RL, x, p + 2 < HG_NSTEP ? p + 2 : HG_NSTEP - 1);
    LAS unsigned char* base = lds + cb * HG_BUF;
    bf16x8 sb[4];
#pragma unroll
    for (int q = 0; q < 4; ++q) { u32x4 sw = {pk2(S[2 * q][0], S[2 * q][1]), pk2(S[2 * q][2], S[2 * q][3]), pk2(S[2 * q + 1][0], S[2 * q + 1][1]), pk2(S[2 * q + 1][2], S[2 * q + 1][3])}; sb[q] = __builtin_bit_cast(bf16x8, sw); }
    const s16x4 vb0 = ds_tr16(base + 3 * HG_TILE + (4 * g + (lv >> 2)) * HG_RN + (16 * w + 4 * (lv & 3)) * 2);
    const s16x4 vb1 = ds_tr16(base + 7 * HG_TILE + (4 * g + (lv >> 2)) * HG_RN + (16 * w + 4 * (lv & 3)) * 2);
    const bf16x8 vb01 = {vb0[0], vb0[1], vb0[2], vb0[3], vb1[0], vb1[1], vb1[2], vb1[3]};
    f32x4 O0, O1;
    bf16x8 ka[4]; hg_frags(ka, base + HG_TILE, lv, g);
    {
        bf16x8 qf[4]; hg_frags(qf, base, lv, g);
        f32x4 X = hg_dot4(ka, qf);
        O0 = hg_dot4(qf, sb);
#pragma unroll
        for (int i = 0; i < 4; ++i) X[i] = (4 * g + i <= lv) ? X[i] : 0.f;
        s16x4 xa; { u32x2 wv = {pk2(X[0], X[1]), pk2(X[2], X[3])}; xa = __builtin_bit_cast(s16x4, wv); }
        O0 = __builtin_amdgcn_mfma_f32_16x16x16bf16_1k(xa, vb0, O0, 0, 0, 0);
    }
    {
        bf16x8 qf[4], kf[4], qs[4]; hg_frags(qf, base + 4 * HG_TILE, lv, g); hg_frags(kf, base + 5 * HG_TILE, lv, g); hg_frags(qs, base + 8 * HG_TILE, lv, g);
        f32x4 Xb = hg_dot4(kf, qf); const f32x4 Xa = hg_dot4(ka, qs);
        O1 = hg_dot4(qs, sb);
#pragma unroll
        for (int i = 0; i < 4; ++i) Xb[i] = (4 * g + i <= lv) ? Xb[i] : 0.f;
        u32x4 wv = {pk2(Xa[0], Xa[1]), pk2(Xa[2], Xa[3]), pk2(Xb[0], Xb[1]), pk2(Xb[2], Xb[3])};
        O1 = __builtin_amdgcn_mfma_f32_16x16x32_bf16(__builtin_bit_cast(bf16x8, wv), vb01, O1, 0, 0, 0);
    }
#pragma unroll
    for (int kt = 0; kt < 8; ++kt) {
        const f32x4 e4 = *(LAS f32x4*)(base + 10 * HG_TILE + (16 * kt + 4 * g) * 4);
        const s16x4 ka = ds_tr16(base + 9 * HG_TILE + (4 * g + (lv >> 2)) * HG_RN + (16 * kt + 4 * (lv & 3)) * 2);
        const s16x4 kb = ds_tr16(base + 6 * HG_TILE + (4 * g + (lv >> 2)) * HG_RN + (16 * kt + 4 * (lv & 3)) * 2);
        const bf16x8 kab = {ka[0], ka[1], ka[2], ka[3], kb[0], kb[1], kb[2], kb[3]};
        S[kt] = S[kt] * e4;
        S[kt] = __builtin_amdgcn_mfma_f32_16x16x32_bf16(kab, vb01, S[kt], 0, 0, 0);
    }
    {   LAS unsigned char* ob = lds + HG_OB_OFF + cb * HG_OBUF + (16 * w + lv) * 4;
#pragma unroll
        for (int i = 0; i < 4; ++i) { *(LAS float*)(ob + (4 * g + i) * HG_OROW) = O0[i]; *(LAS float*)(ob + (16 + 4 * g + i) * HG_OROW) = O1[i]; }
        f32x4 q0 = O0 * O0, q1 = O1 * O1;
#pragma unroll
        for (int i = 0; i < 4; ++i) { q0[i] = row_sum16(q0[i]); q1[i] = row_sum16(q1[i]); }
        if (lv == 0) {
#pragma unroll
            for (int i = 0; i < 4; ++i) { *(LAS float*)(lds + HG_SQ_OFF + ((cb * 32 + 4 * g + i) * 8 + w) * 4) = q0[i]; *(LAS float*)(lds + HG_SQ_OFF + ((cb * 32 + 16 + 4 * g + i) * 8 + w) * 4) = q1[i]; } }
    }
    if (p + 1 < HG_NSTEP) { hg_fix_last(RS, p + 1); hg_store(RS, x, lds, cb ^ 1); }
    const u32x2 sgn0 = RS.sg0, sgn1 = RS.sg1;
    __syncthreads();
#pragma unroll
    for (int j = 0; j < 2; ++j) {
        if (j == 1 && 2 * p + 1 >= NCHUNK) break;
        const int trow = 16 * j + x.srow;
        const f32x4 o4 = *(LAS f32x4*)(lds + HG_OB_OFF + cb * HG_OBUF + trow * HG_OROW + x.sseg * 16);
        const f32x4 pa = *(LAS f32x4*)(lds + HG_SQ_OFF + (cb * 32 + trow) * 32), pb = *(LAS f32x4*)(lds + HG_SQ_OFF + (cb * 32 + trow) * 32 + 16);
        const float ss = ((pa[0] + pa[1]) + (pa[2] + pa[3])) + ((pb[0] + pb[1]) + (pb[2] + pb[3]));
        const float rstd = rsqrtf(ss * (1.0f / 128.0f) + EPS);
        const u32x2 sg = j ? sgc1 : sgc0;
        u32x2 ov; ov.x = pk2(o4[0] * rstd * bf_lo(sg.x), o4[1] * rstd * bf_hi(sg.x)); ov.y = pk2(o4[2] * rstd * bf_lo(sg.y), o4[3] * rstd * bf_hi(sg.y));
        *(u32x2*)(x.A2 + (size_t)(2 * p + j) * (16 * LDK * 2) + x.aoff) = ov;
    }
    sgc0 = sgn0; sgc1 = sgn1;
}
__device__ __forceinline__ void hg_prompt_unit(LAS unsigned char* lds, int b, int h, const bf16_t* QT, const bf16_t* KT, const bf16_t* KD, const bf16_t* V, const bf16_t* SG, const float* EBL, bf16_t* A2, float* outS) {
    HgCtx x;
    x.tid = opaque_tid(); const int lane = x.tid & 63; x.w = __builtin_amdgcn_readfirstlane(x.tid >> 6); x.lv = lane & 15; x.g = lane >> 4; x.srow = x.tid >> 5; x.sseg = x.tid & 31;
    const size_t rowbase = (size_t)b * TP; const int colbase = h * 128;
    {   const size_t ub = (size_t)(b * 32 + h) * TP * 128 * 2;
        x.QT = (const char*)QT + ub; x.KT = (const char*)KT + ub; x.V = (const char*)V + ub; x.SG = (const char*)SG + ub;
        x.A2 = (char*)A2 + (rowbase * LDK + colbase) * 2;
        x.EB = (const char*)EBL + (size_t)(b * 32 + h) * NCHUNK * 128 * 4;
        x.toff = (unsigned)x.tid * 8u; x.eoff = (unsigned)(4 * x.sseg) * 4u; x.aoff = (unsigned)(x.srow * LDK + 4 * x.sseg) * 2u; }
    f32x4 S[8];
#pragma unroll
    for (int i = 0; i < 8; ++i) S[i] = (f32x4){0.f, 0.f, 0.f, 0.f};
    HgRegs R0, R1;
    hg_load(R0, x, 0); hg_store(R0, x, lds, 0); u32x2 sgc0 = R0.sg0, sgc1 = R0.sg1; hg_load(R1, x, 1);
    __syncthreads();
    for (int p = 0; p < HG_NSTEP; p += 2) {
        hg_step(S, R0, R1, sgc0, sgc1, x, lds, p);
        if (p + 1 < HG_NSTEP) hg_step(S, R1, R0, sgc0, sgc1, x, lds, p + 1);
    }
    float* so = outS + ((size_t)(b * 32 + h) * 128) * 128 + 16 * x.w + x.lv;
#pragma unroll
    for (int kt = 0; kt < 8; ++kt)
#pragma unroll
        for (int i = 0; i < 4; ++i) so[(size_t)(16 * kt + 4 * x.g + i) * 128] = S[kt][i];
    __syncthreads();
}
__device__ __forceinline__ void hg_sample_unit(LAS unsigned char* lds, int s, int h, const bf16_t* QT, const bf16_t* KT, const bf16_t* KD, const bf16_t* V, const bf16_t* SG, const float* S0, float* S1, bf16_t* A2) {
    const int tid = opaque_tid(), kg = tid >> 5, c4 = tid & 31;
    const size_t ro = ((size_t)BATCH * 32 * TP + (size_t)s * 32 + h) * 128;
    const u32x4 qw = *(const u32x4*)(QT + ro + 8 * kg), kw = *(const u32x4*)(KT + ro + 8 * kg);
    const u32x2 vw = *(const u32x2*)(V + ro + 4 * c4);
    const f32x4 v4 = {bf_lo(vw.x), bf_hi(vw.x), bf_lo(vw.y), bf_hi(vw.y)};
    float qv[8] = {bf_lo(qw.x), bf_hi(qw.x), bf_lo(qw.y), bf_hi(qw.y), bf_lo(qw.z), bf_hi(qw.z), bf_lo(qw.w), bf_hi(qw.w)};
    float kv[8] = {bf_lo(kw.x), bf_hi(kw.x), bf_lo(kw.y), bf_hi(kw.y), bf_lo(kw.z), bf_hi(kw.z), bf_lo(kw.w), bf_hi(kw.w)};
    float fv[8];
#pragma unroll
    for (int i = 0; i < 8; ++i) fv[i] = 1.0f - kv[i];
    const size_t so = (((size_t)s * 32 + h) * 128 + 8 * kg) * 128 + 4 * c4;
    f32x4 oa = {0.f, 0.f, 0.f, 0.f};
#pragma unroll
    for (int i = 0; i < 8; ++i) { const f32x4 s4 = __builtin_nontemporal_load((const f32x4*)(S0 + so + i * 128)); const f32x4 n4 = s4 * fv[i] + v4 * kv[i]; __builtin_nontemporal_store(n4, (f32x4*)(S1 + so + i * 128)); oa += n4 * qv[i]; }
    *(LAS f32x4*)(lds + (kg * 128 + 4 * c4) * 4) = oa;
    __syncthreads();
    if (tid < 32) {
        f32x4 o4 = {0.f, 0.f, 0.f, 0.f};
#pragma unroll
        for (int k = 0; k < 16; ++k) o4 += *(LAS f32x4*)(lds + (k * 128 + 4 * tid) * 4);
        float ss = (o4[0] * o4[0] + o4[1] * o4[1]) + (o4[2] * o4[2] + o4[3] * o4[3]);
#pragma unroll
        for (int o = 1; o < 32; o <<= 1) ss += __shfl_xor(ss, o);
        const float rstd = rsqrtf(ss * (1.0f / 128.0f) + EPS);
        const u32x2 sg = *(const u32x2*)(SG + ro + 4 * tid);
        u32x2 ov; ov.x = pk2(o4[0] * rstd * bf_lo(sg.x), o4[1] * rstd * bf_hi(sg.x)); ov.y = pk2(o4[2] * rstd * bf_lo(sg.y), o4[3] * rstd * bf_hi(sg.y));
        *(u32x2*)(A2 + (size_t)(MPROMPT + s) * LDK + h * 128 + 4 * tid) = ov;
    }
    __syncthreads();
}

__device__ __forceinline__ u32x4 attn_ldblk(const bf16_t* K3, const bf16_t* V3, int b, int n, int tblk, int tid) {
    const int row = tid >> 4, ch = tid & 15, tok = 32 * tblk + row; u32x4 v = {0u, 0u, 0u, 0u};
    if (tok >= 0 && tok < TP) { const size_t o = ((size_t)b * TP + tok) * 512 + n * 64 + (ch & 7) * 8; v = *(const u32x4*)((ch < 8 ? K3 : V3) + o); }
    return v;
}
constexpr int AT_KR = 144, AT_KOFF = 0, AT_VOFF = 6 * 32 * AT_KR, AT_BTOFF = 2 * AT_VOFF, AT_DOFF = AT_BTOFF + 8 * 192 * 4, AT_OOFF = AT_DOFF + 8 * 32 * 4, AT_OROW = 272, AT_OWAVE = 32 * AT_OROW;
static_assert(AT_OOFF + 8 * AT_OWAVE <= MISC_OFF && AT_OOFF % 16 == 0, "attention LDS map");
__device__ __forceinline__ void attn_stblk(LAS unsigned char* lds, u32x4 v, int tblk, int tid) {
    const int row = tid >> 4, ch = tid & 15, slot = (tblk + 8) % 6;
    *(LAS u32x4*)(lds + (ch < 8 ? AT_KOFF : AT_VOFF) + (slot * 32 + row) * AT_KR + (ch & 7) * 16) = v;
}
__device__ __forceinline__ void attn_ldq(bf16x8 (&qf)[4], const bf16_t* Q3, int b, int h, int qb, int q, int hh) {
    const int tq = (32 * qb + q < TP) ? 32 * qb + q : TP - 1; const bf16_t* qp = Q3 + ((size_t)b * TP + tq) * D + h * 64 + 8 * hh;
#pragma unroll
    for (int ds = 0; ds < 4; ++ds) qf[ds] = *(const bf16x8*)(qp + 16 * ds);
}
__device__ __forceinline__ void attn_prompt_run(LAS unsigned char* lds, int b, int n, int qlo, int qhi, const bf16_t* Q3, const bf16_t* K3, const bf16_t* V3, const bf16_t* SG3, const float* BT, const float* sinks, bf16_t* A4) {
    const int tid = opaque_tid(), lane = tid & 63, w = __builtin_amdgcn_readfirstlane(tid >> 6), q = lane & 31, hh = lane >> 5, lv = lane & 15, G = lane >> 4;
    const int h = 8 * n + w;
    {   u32x4 r5[5];
#pragma unroll
        for (int k = 0; k < 5; ++k) r5[k] = attn_ldblk(K3, V3, b, n, qlo - 4 + k, tid);
#pragma unroll
        for (int k = 0; k < 5; ++k) attn_stblk(lds, r5[k], qlo - 4 + k, tid); }
    for (int i = tid; i < 8 * 192; i += 512) { const int x = i / 192, idx = i - x * 192, dist = 159 - idx;
        *(LAS float*)(lds + AT_BTOFF + i * 4) = (dist >= 0 && dist <= WIN) ? BT[(8 * n + x) * 132 + dist] : -1e30f; }
    u32x4 nreg = attn_ldblk(K3, V3, b, n, qlo + 1, tid);
    bf16x8 qn[4]; attn_ldq(qn, Q3, b, h, qlo, q, hh);
    const float sink = sinks[h] * 1.4426950408889634f;
    LAS unsigned char* tbp = lds + AT_BTOFF + (w * 192 + (31 - q) + 4 * hh) * 4;
    LAS unsigned char* ost = lds + AT_OOFF + w * AT_OWAVE;
    __syncthreads();
    for (int i = qlo; i < qhi; ++i) {
        const int t0 = 32 * i;
        if (i + 1 < qhi) attn_stblk(lds, nreg, i + 1, tid);
        if (i + 2 < qhi) nreg = attn_ldblk(K3, V3, b, n, i + 2, tid);
        bf16x8 qf[4];
#pragma unroll
        for (int ds = 0; ds < 4; ++ds) qf[ds] = qn[ds];
        if (i + 1 < qhi) attn_ldq(qn, Q3, b, h, i + 1, q, hh);
        u32x4 sgv[4];
#pragma unroll
        for (int it = 0; it < 4; ++it) { const int tq = t0 + it * 8 + (lane >> 3); sgv[it] = (u32x4){0u, 0u, 0u, 0u}; if (tq < TP) sgv[it] = *(const u32x4*)(SG3 + ((size_t)b * TP + tq) * D + h * 64 + (lane & 7) * 8); }
        int so[5];
#pragma unroll
        for (int kb = 0; kb < 5; ++kb) so[kb] = ((i - 4 + kb + 8) % 6) * 32 * AT_KR;
        f32x16 p[5];
#pragma unroll
        for (int kb = 0; kb < 5; ++kb) {
#pragma unroll
            for (int r = 0; r < 16; ++r) p[kb][r] = *(LAS float*)(tbp + (32 * kb + (r & 3) + 8 * (r >> 2)) * 4);
#pragma unroll
            for (int ds = 0; ds < 4; ++ds) { const bf16x8 kf = *(LAS bf16x8*)(lds + AT_KOFF + so[kb] + q * AT_KR + (16 * ds + 8 * hh) * 2); p[kb] = __builtin_amdgcn_mfma_f32_32x32x16_bf16(kf, qf[ds], p[kb], 0, 0, 0); }
        }
        if (t0 < 128) {
            const int jmin = 128 - t0 - 4 * hh;
#pragma unroll
            for (int kb = 0; kb < 4; ++kb)
#pragma unroll
                for (int r = 0; r < 16; ++r) { const int jc = 32 * kb + (r & 3) + 8 * (r >> 2); p[kb][r] = (jc >= jmin) ? p[kb][r] : -1e30f; }
        }
        float mx = sink;
#pragma unroll
        for (int kb = 0; kb < 5; ++kb)
#pragma unroll
            for (int r = 0; r < 16; r += 2) mx = fmaxf(mx, fmaxf(p[kb][r], p[kb][r + 1]));
        mx = fmaxf(mx, __shfl_xor(mx, 32));
        float sum = 0.f;
#pragma unroll
        for (int kb = 0; kb < 5; ++kb)
#pragma unroll
            for (int r = 0; r < 16; ++r) { const float e = __builtin_amdgcn_exp2f(p[kb][r] - mx); p[kb][r] = e; sum += e; }
        sum += __shfl_xor(sum, 32);
        const float rden = 1.0f / (sum + __builtin_amdgcn_exp2f(sink - mx));
        if (hh == 0) *(LAS float*)(lds + AT_DOFF + (w * 32 + q) * 4) = rden;
        f32x16 o[2];
#pragma unroll
        for (int r = 0; r < 16; ++r) { o[0][r] = 0.f; o[1][r] = 0.f; }
#pragma unroll
        for (int kb = 0; kb < 5; ++kb)
#pragma unroll
            for (int ks = 0; ks < 2; ++ks) {
                u32x4 pw = {pk2(p[kb][8 * ks + 0], p[kb][8 * ks + 1]), pk2(p[kb][8 * ks + 2], p[kb][8 * ks + 3]), pk2(p[kb][8 * ks + 4], p[kb][8 * ks + 5]), pk2(p[kb][8 * ks + 6], p[kb][8 * ks + 7])};
                const bf16x8 pa = __builtin_bit_cast(bf16x8, pw);
                const int rowb = 16 * ks + 4 * hh + (lv >> 2);
#pragma unroll
                for (int db = 0; db < 2; ++db) {
                    LAS unsigned char* vp = lds + AT_VOFF + so[kb] + rowb * AT_KR + (32 * db + 16 * (G & 1) + 4 * (lv & 3)) * 2;
                    const s16x4 t0v = ds_tr16(vp), t1v = ds_tr16(vp + 8 * AT_KR);
                    const bf16x8 vb = {t0v[0], t0v[1], t0v[2], t0v[3], t1v[0], t1v[1], t1v[2], t1v[3]};
                    o[db] = __builtin_amdgcn_mfma_f32_32x32x16_bf16(pa, vb, o[db], 0, 0, 0);
                }
            }
#pragma unroll
        for (int db = 0; db < 2; ++db)
#pragma unroll
            for (int r = 0; r < 16; ++r) *(LAS float*)(ost + ((r & 3) + 8 * (r >> 2) + 4 * hh) * AT_OROW + (32 * db + q) * 4) = o[db][r];
#pragma unroll
        for (int it = 0; it < 4; ++it) {
            const int row = it * 8 + (lane >> 3), ch = lane & 7, tq = t0 + row;
            const f32x4 a0 = *(LAS f32x4*)(ost + row * AT_OROW + ch * 32), a1 = *(LAS f32x4*)(ost + row * AT_OROW + ch * 32 + 16);
            const float rd = *(LAS float*)(lds + AT_DOFF + (w * 32 + row) * 4);
            if (tq < TP) {
                const u32x4 sg = sgv[it];
                u32x4 ov;
                ov.x = pk2(a0[0] * rd * bf_lo(sg.x), a0[1] * rd * bf_hi(sg.x)); ov.y = pk2(a0[2] * rd * bf_lo(sg.y), a0[3] * rd * bf_hi(sg.y));
                ov.z = pk2(a1[0] * rd * bf_lo(sg.z), a1[1] * rd * bf_hi(sg.z)); ov.w = pk2(a1[2] * rd * bf_lo(sg.w), a1[3] * rd * bf_hi(sg.w));
                *(u32x4*)(A4 + ((size_t)b * TP + tq) * LDK + h * 64 + ch * 8) = ov;
            }
        }
        __syncthreads();
    }
}
__device__ __forceinline__ void attn_sample_unit(LAS unsigned char* lds, int s, int n, const bf16_t* Q3, const bf16_t* K3, const bf16_t* V3, const bf16_t* SG3, const float* BT, const float* sinks,
                                                 const float* ck, const float* cv, float* oks, float* ovs, bf16_t* A4) {
    const int tid = opaque_tid(), lane = tid & 63, w = __builtin_amdgcn_readfirstlane(tid >> 6);
    constexpr int KS = 0, VS = 33792, QS = 67584, PS = 69632;
    LAS float* ksm = (LAS float*)(lds + KS); LAS float* vsm = (LAS float*)(lds + VS); LAS float* qsm = (LAS float*)(lds + QS); LAS float* psm = (LAS float*)(lds + PS);
    const int r = MPROMPT + s, h = 8 * n + w;
    for (int i = tid; i < 128 * 16; i += 512) {
        const int row = i >> 4, c4 = i & 15; const size_t o = (((size_t)s * 128 + row) * 8 + n) * 64 + 4 * c4;
        const f32x4 k4 = *(const f32x4*)(ck + o), v4 = *(const f32x4*)(cv + o);
#pragma unroll
        for (int j = 0; j < 4; ++j) { ksm[row * 65 + 4 * c4 + j] = k4[j]; vsm[row * 65 + 4 * c4 + j] = v4[j]; }
    }
    if (tid < 64) { ksm[128 * 65 + tid] = bf1(K3[(size_t)r * 512 + n * 64 + tid]); vsm[128 * 65 + tid] = bf1(V3[(size_t)r * 512 + n * 64 + tid]); }
    qsm[w * 64 + lane] = bf1(Q3[(size_t)r * D + h * 64 + lane]);
    __syncthreads();
    for (int i = tid; i < 128 * 64; i += 512) { const int rr = i >> 6, d = i & 63; const size_t o = (((size_t)s * 128 + rr) * 8 + n) * 64 + d; oks[o] = ksm[(rr + 1) * 65 + d]; ovs[o] = vsm[(rr + 1) * 65 + d]; }
    float s0 = 0.f, s1 = 0.f, s2 = 0.f;
    for (int d = 0; d < 64; ++d) { const float qd = qsm[w * 64 + d]; s0 += qd * ksm[lane * 65 + d]; s1 += qd * ksm[(lane + 64) * 65 + d]; s2 += qd * ksm[128 * 65 + d]; }
    s0 += BT[h * 132 + (128 - lane)]; s1 += BT[h * 132 + (64 - lane)]; s2 += BT[h * 132];
    float mx = fmaxf(s0, fmaxf(s1, s2));
#pragma unroll
    for (int o = 1; o < 64; o <<= 1) mx = fmaxf(mx, __shfl_xor(mx, o));
    const float sink = sinks[h] * 1.4426950408889634f; mx = fmaxf(mx, sink);
    const float p0 = __builtin_amdgcn_exp2f(s0 - mx), p1 = __builtin_amdgcn_exp2f(s1 - mx), p2 = __builtin_amdgcn_exp2f(s2 - mx);
    float sum = wave_sum(p0 + p1) + p2;
    const float rden = 1.0f / (sum + __builtin_amdgcn_exp2f(sink - mx));
    psm[w * 132 + lane] = p0; psm[w * 132 + 64 + lane] = p1; if (lane == 0) psm[w * 132 + 128] = p2;
    float oa = 0.f;
    for (int j = 0; j < 129; ++j) oa += psm[w * 132 + j] * vsm[j * 65 + lane];
    const size_t go = (size_t)r * D + h * 64 + lane;
    const float outv = oa * rden * bf1(SG3[go]);
    A4[(size_t)r * LDK + h * 64 + lane] = (bf16_t)(pk2(outv, 0.f) & 0xffffu);
    __syncthreads();
}


#define XB_TMO      128
#define XB_XCNT(j)  (256  + 64 * (j))
#define XB_XSUB(j)  (1280 + 64 * (j))
#define XB_XGEN(j)  (2304 + 64 * (j))
#define XB_TOP      3328
#define XB_TOPGEN   3392
#define XCD_BAR_WORDS 3456
#define XB_SPIN_CAP (1u << 20)
__device__ __forceinline__ unsigned xb_ld(unsigned* p)              { return __hip_atomic_load(p, __ATOMIC_RELAXED, __HIP_MEMORY_SCOPE_AGENT); }
__device__ __forceinline__ unsigned xb_add(unsigned* p, unsigned v) { return __hip_atomic_fetch_add(p, v, __ATOMIC_RELAXED, __HIP_MEMORY_SCOPE_AGENT); }
__device__ __forceinline__ unsigned xb_xcc_id() { return (unsigned)__builtin_amdgcn_s_getreg((3 << 11) | 20) & 0xFu; }
#define XB_SPIN(cond, bar) do { unsigned _sp = 0; while (cond) { __builtin_amdgcn_s_sleep(1); \
    if ((++_sp & 255u) == 0u) { if (xb_ld(&(bar)[XB_TMO])) break; if (_sp > XB_SPIN_CAP) { atomicAdd(&(bar)[XB_TMO], 1u); break; } } } } while (0)
struct XcdBarrier { unsigned* bar; unsigned x; volatile LAS unsigned* st; unsigned nloc, nx; };
__device__ __forceinline__ XcdBarrier xcd_barrier_post(unsigned* bar, volatile LAS unsigned* st) {
    XcdBarrier b; b.bar = bar; b.x = xb_xcc_id(); b.st = st; b.nloc = 0u; b.nx = 0u;
    if (threadIdx.x == 0) (void)xb_add(&bar[XB_XCNT(b.x)], 1u);
    return b;
}
__device__ __forceinline__ void xcd_barrier_complete(unsigned* bar, unsigned x, unsigned& nloc, unsigned& nx) {
    const unsigned G = gridDim.x * gridDim.y * gridDim.z;
    unsigned sum, cnt, mine, sp = 0u;
    for (;;) {
        sum = 0u; cnt = 0u; mine = 0u;
#pragma unroll
        for (unsigned j = 0; j < 16; ++j) { const unsigned c = xb_ld(&bar[XB_XCNT(j)]); sum += c; cnt += (c > 0u) ? 1u : 0u; mine = (j == x) ? c : mine; }
        if (sum == G) break;
        __builtin_amdgcn_s_sleep(1);
        if ((++sp & 255u) == 0u) { if (xb_ld(&bar[XB_TMO])) break; if (sp > XB_SPIN_CAP) { atomicAdd(&bar[XB_TMO], 1u); break; } }
    }
    nloc = mine > 0u ? mine : 1u; nx = cnt > 0u ? cnt : 1u;
}
__device__ __forceinline__ void xcd_barrier(XcdBarrier& b) {
    asm volatile("s_waitcnt vmcnt(0)" ::: "memory");
    __syncthreads();
    if (threadIdx.x == 0) {
        unsigned* bar = b.bar;
        __builtin_amdgcn_s_waitcnt(0);
        unsigned nloc = b.nloc, nx = b.nx;
        if (nloc == 0u) { xcd_barrier_complete(bar, b.x, nloc, nx); b.st[0] = nloc; b.st[1] = nx; }
        const unsigned old = xb_add(&bar[XB_XSUB(b.x)], 1u);
        const unsigned gen = old / nloc;
        if (old + 1u == (gen + 1u) * nloc) {
            __builtin_amdgcn_fence(__ATOMIC_RELEASE, "agent");
            asm volatile("s_waitcnt vmcnt(0)" ::: "memory");
            const unsigned og = xb_add(&bar[XB_TOP], 1u);
            const unsigned tg = og / nx;
            if (og + 1u == (tg + 1u) * nx) xb_add(&bar[XB_TOPGEN], 1u);
            else XB_SPIN(xb_ld(&bar[XB_TOPGEN]) == tg, bar);
            __builtin_amdgcn_fence(__ATOMIC_ACQUIRE, "agent");
            xb_add(&bar[XB_XGEN(b.x)], 1u);
            asm volatile("s_waitcnt vmcnt(0)" ::: "memory");
        } else {
            XB_SPIN(xb_ld(&bar[XB_XGEN(b.x)]) == gen, bar);
            __builtin_amdgcn_fence(__ATOMIC_ACQUIRE, "agent");
            asm volatile("s_waitcnt vmcnt(0)" ::: "memory");
        }
    }
    __syncthreads();
    if (b.nloc == 0u) { b.nloc = __builtin_amdgcn_readfirstlane(b.st[0]); b.nx = __builtin_amdgcn_readfirstlane(b.st[1]); }
}

struct UnitSync { XcdBarrier b; __device__ __forceinline__ void sync() const { XcdBarrier t = b; xcd_barrier(t); } };
#ifndef USYNC3
#define USYNC3 0
#endif
__global__ void __launch_bounds__(512, 2) hgswa_fwd(Args args) {
    extern __shared__ __attribute__((aligned(16))) unsigned char lds_raw[];
    LAS unsigned char* lds = (LAS unsigned char*)lds_raw;
    const int G = gridDim.x, c = blockIdx.x;
    unsigned char* ws = args.ws;
    const int lo = args.ph_lo, hi = args.ph_hi, sub = args.sub;
    float* SLAB = (float*)(ws + WS_SLAB);
    XcdBarrier xbar; xbar.bar = (unsigned*)(ws + WS_CTL); xbar.x = 0; xbar.st = (volatile LAS unsigned*)(lds + MISC_OFF); xbar.nloc = 0u; xbar.nx = 0u;
    if (args.sync) {
        if (threadIdx.x < 2) ((volatile LAS unsigned*)(lds + MISC_OFF))[threadIdx.x] = 0u;
        __syncthreads();
        xbar = xcd_barrier_post((unsigned*)(ws + WS_CTL), (volatile LAS unsigned*)(lds + MISC_OFF));
    }
    UnitSync usn; usn.b = xbar;
#define IN(k) (lo <= (k) && (k) < hi)
#define GRIDBAR() xcd_barrier(xbar)
#define SEAM(k) do { if (IN(k) && IN((k) + 1)) { GRIDBAR(); } } while (0)
    bf16_t* B0 = (bf16_t*)(ws + WS_B0); bf16_t* B1 = (bf16_t*)(ws + WS_B0 + BUFB); bf16_t* B2 = (bf16_t*)(ws + WS_B0 + 2 * BUFB); bf16_t* B3 = (bf16_t*)(ws + WS_B0 + 3 * BUFB);
    bf16_t* B4 = (bf16_t*)(ws + WS_B0 + 4 * BUFB); bf16_t* B5 = (bf16_t*)(ws + WS_B0 + 5 * BUFB);
    float* X1 = (float*)(ws + WS_X1); float* EBL = (float*)(ws + WS_EBL);
    bf16_t* K3 = (bf16_t*)(ws + WS_K3); bf16_t* V3 = (bf16_t*)(ws + WS_V3);
    unsigned long long* SSQ1 = (unsigned long long*)(ws + WS_SSQ1); unsigned long long* SSQ2 = (unsigned long long*)(ws + WS_SSQ2);
    const float* BT = (const float*)(ws + WS_BT);

    for (int rep_ = 0; rep_ < (PROBE_PHASE == 0 ? 2 : 1); ++rep_) { if (rep_) GRIDBAR();
    if (IN(0)) { p0_prep(args, G, lds); }
        }
    SEAM(0);
    for (int rep_ = 0; rep_ < (PROBE_PHASE == 1 ? 2 : 1); ++rep_) { if (rep_) GRIDBAR();
    if (IN(1)) {
        pg8::Gemm g{B0, (const bf16_t*)(ws + WS_W1), MP, N1, D, LDK}; pg8::TailOrder<4, 0, 0> S; S.init(MFULL, N1, G, c);
        EpiHg E{B1, B2, B3, B4, B5, EBL, (const float*)(ws + WS_RSTD0), (const float*)(ws + WS_LB)};
        if (sub != 2) pg8::gemm_phase<EpiHg, pg8::TailOrder<4, 0, 0>, true, PGSP2, UnitSync>(lds, g, S, E, SLAB, usn, false, 0);
        if (sub == 0) GRIDBAR();
        if (sub != 1) pg8::gemm_tail_fixup<4, EpiHg>(SLAB, N1 / 256, MFULL / 256, G, c, E);
    }
        }
    SEAM(1);
    for (int rep_ = 0; rep_ < ((PROBE_PHASE == 2 || PROBE_PHASE == 12 || PROBE_PHASE == 13) ? 2 : 1); ++rep_) { if (rep_) GRIDBAR();
    if (IN(2)) {
        if (G == 256) {
            if (c < 128) { if (!(rep_ == 1 && PROBE_PHASE == 13)) hg_prompt_unit(lds, c >> 5, c & 31, B1, B2, B3, B4, B5, EBL, B3, args.out + O_SP); }
            else if (!(rep_ == 1 && PROBE_PHASE == 12)) {
                for (int u = c - 128; u < NS * 32; u += 128) hg_sample_unit(lds, u >> 5, u & 31, B1, B2, B3, B4, B5, args.in[I_STATE], args.out + O_SS, B3);
                const int tid = opaque_tid(), wv = tid >> 6, ln = tid & 63; constexpr int CR = WC2 + WC3; LAS unsigned char* scr = lds + wv * WSCR;
                w_convert1(args, (c - 128) * 8 + wv, CR * 64, 1024, CR, WC1, ln, scr);
            }
        } else {
            for (int u = c; u < 128 + NS * 32; u += G) {
                if (u < 128) hg_prompt_unit(lds, u >> 5, u & 31, B1, B2, B3, B4, B5, EBL, B3, args.out + O_SP);
                else hg_sample_unit(lds, (u - 128) >> 5, (u - 128) & 31, B1, B2, B3, B4, B5, args.in[I_STATE], args.out + O_SS, B3);
            }
        }
    }
        }
    SEAM(2);
    if (IN(3)) {
        pg8::Gemm g{B3, (const bf16_t*)(ws + WS_W2), MP, N2, D, LDK}; pg8::TailOrder<16, 0, 0> S; S.init(MFULL, N2, G, c);
        EpiRes E{B0, B1, SSQ1};
        if (sub != 2) pg8::gemm_phase<EpiRes, pg8::TailOrder<16, 0, 0>, true, PGSP2, UnitSync>(lds, g, S, E, SLAB, usn, false, 0);
        if (sub == 0) GRIDBAR();
        if (sub != 1) pg8::gemm_tail_fixup<16, EpiRes>(SLAB, N2 / 256, MFULL / 256, G, c, E);
    }
    SEAM(3);
    for (int rep_ = 0; rep_ < ((PROBE_PHASE == 4 || (PROBE_PHASE >= 400 && PROBE_PHASE <= 405)) ? 2 : 1); ++rep_) { if (rep_) GRIDBAR();
    if (IN(4)) {
        pg8::Gemm g{B1, (const bf16_t*)(ws + WS_W3), MP, N3, D, LDK}; pg8::StaticOrder S; S.init(MP, N3, G, c);
        EpiSw E{B2, K3, V3, B3, SSQ1};
        if (rep_ == 0 || PROBE_PHASE == 4) pg8::gemm_phase<EpiSw, pg8::StaticOrder, true, PGSP2, UnitSync>(lds, g, S, E, nullptr, usn, (USYNC3 && args.sync), (MP / 256 * (N3 / 256) + G - 1) / G);
        else { EpiDummy ED{SLAB}; constexpr int AB = (PROBE_PHASE >= 400 && PROBE_PHASE <= 405) ? PROBE_PHASE - 400 : 0;
            pg8::gemm_phase<EpiDummy, pg8::StaticOrder, true, PGSP2, UnitSync, AB>(lds, g, S, ED, nullptr, usn, false, 0); }
        if (G == 256 && rep_ == 0) {
            constexpr int NU3 = (MP / 256) * (N3 / 256), NFULL = NU3 % 256, NIDLE = 256 - NFULL;
            if (c >= NFULL) { const int tid = opaque_tid(); w_convert(args, (c - NFULL) * 8 + (tid >> 6), WC4 * 64, NIDLE * 8, WC4, WC1 + WC2 + WC3, tid & 63, lds + (tid >> 6) * WSCR); }
        }
    }
        }
    SEAM(4);
    for (int rep_ = 0; rep_ < (PROBE_PHASE == 5 ? 2 : 1); ++rep_) { if (rep_) GRIDBAR();
    if (IN(5)) {
        {   float* okp = args.out + O_KP; float* ovp = args.out + O_VP; const int tid = opaque_tid();
            for (int i = c * 512 + tid; i < BATCH * 128 * 512; i += G * 512) { const int b = i >> 16, rr = (i >> 9) & 127, cc = i & 511; const size_t o = ((size_t)b * TP + (TP - 128) + rr) * 512 + cc; okp[i] = bf1(K3[o]); ovp[i] = bf1(V3[o]); } }
        constexpr int NQB = (TP + 31) / 32;
        {   const int GR = G >= 32 ? G / 32 : 1;
            for (int grp = c / GR; grp < BATCH * 8; grp += (G + GR - 1) / GR) {
                const int jr = c % GR, qlo = (NQB * jr) / GR, qhi = (NQB * (jr + 1)) / GR;
                attn_prompt_run(lds, grp >> 3, grp & 7, qlo, qhi, B2, K3, V3, B3, BT, args.in[I_SWSINK], B4);
            }
        }
        for (int v = c; v < NS * 8; v += G) attn_sample_unit(lds, v >> 3, v & 7, B2, K3, V3, B3, BT, args.in[I_SWSINK], args.in[I_CK], args.in[I_CV], args.out + O_KS, args.out + O_VS, B4);
    }
        }
    SEAM(5);
    if (IN(6)) {
        pg8::Gemm g{B4, (const bf16_t*)(ws + WS_W4), MP, N4, D, LDK}; pg8::TailOrder<16, 0, 0> S; S.init(MFULL, N4, G, c);
        EpiRes E{B1, B1, SSQ2};
        if (sub != 2) pg8::gemm_phase<EpiRes, pg8::TailOrder<16, 0, 0>, true, PGSP2, UnitSync>(lds, g, S, E, SLAB, usn, false, 0);
        if (sub == 0) GRIDBAR();
        if (sub != 1) pg8::gemm_tail_fixup<16, EpiRes>(SLAB, N4 / 256, MFULL / 256, G, c, E);
    }
    SEAM(6);
    for (int rep_ = 0; rep_ < (PROBE_PHASE == 7 ? 2 : 1); ++rep_) { if (rep_) GRIDBAR();
    if (IN(7)) {
        const int tid = opaque_tid(), lane = tid & 63, gw = c * 8 + (tid >> 6), NGW = G * 8; const float* fn = args.in[I_FNORM];
        for (int r = gw; r < MV; r += NGW) {
            float* dst;
            if (r < MPROMPT) { const int b = r / TP, t = r - b * TP; if (t < NMETA) continue; dst = args.out + O_YP + ((size_t)b * SEQ + (t - NMETA)) * D; }
            else dst = args.out + O_YS + (size_t)(r - MPROMPT) * D;
            const float rs = rstd_from_ssq(SSQ2[r]); const bf16_t* src = B1 + (size_t)r * LDK;
#pragma unroll
            for (int j = 0; j < 8; ++j) { const int o = j * 512 + lane * 8; const u32x4 xw = *(const u32x4*)(src + o); const f32x4 g0 = *(const f32x4*)(fn + o), g1 = *(const f32x4*)(fn + o + 4);
                const f32x4 x0 = {bf_lo(xw.x), bf_hi(xw.x), bf_lo(xw.y), bf_hi(xw.y)}, x1 = {bf_lo(xw.z), bf_hi(xw.z), bf_lo(xw.w), bf_hi(xw.w)};
                __builtin_nontemporal_store(x0 * rs * g0, (f32x4*)(dst + o)); __builtin_nontemporal_store(x1 * rs * g1, (f32x4*)(dst + o + 4)); }
        }
    }
    }
    #undef IN
#undef SEAM
#undef GRIDBAR
}

extern "C" void kernel_launch(void* const* d_in, const int* in_sizes, int n_in, void* d_out, int out_size, void* d_ws, size_t ws_size, hipStream_t stream) {
    static int grid = 0;
    if (grid == 0) {
        if (n_in != 17 || (size_t)out_size != O_END || ws_size < WS_END) { fprintf(stderr, "kernel_launch: unexpected shapes (n_in %d, out %d, ws %zu)\n", n_in, out_size, ws_size); grid = -1; return; }
        int dev = 0, cus = 0, per_cu = 0;
        if (hipGetDevice(&dev) != hipSuccess || hipDeviceGetAttribute(&cus, hipDeviceAttributeMultiprocessorCount, dev) != hipSuccess) { grid = -1; return; }
        if (hipFuncSetAttribute((const void*)hgswa_fwd, hipFuncAttributeMaxDynamicSharedMemorySize, LDS_BYTES) != hipSuccess) { fprintf(stderr, "kernel_launch: hipFuncSetAttribute failed\n"); grid = -1; return; }
        if (hipOccupancyMaxActiveBlocksPerMultiprocessor(&per_cu, (const void*)hgswa_fwd, 512, LDS_BYTES) != hipSuccess || per_cu < 1) { fprintf(stderr, "kernel_launch: occupancy query says %d blocks per CU\n", per_cu); grid = -1; (void)hipGetLastError(); return; }
        grid = cus;
    }
    if (grid < 0) return;
    (void)hipMemsetAsync((char*)d_ws + WS_CTL, 0, CTL_ZERO_BYTES, stream);
    Args a{};
    for (int i = 0; i < 17; ++i) a.in[i] = (const float*)d_in[i];
    a.out = (float*)d_out; a.ws = (unsigned char*)d_ws;
#if MK_N_LAUNCHES == 1
    a.ph_lo = 0; a.ph_hi = 8; a.sync = 1;
    void* kargs[] = {&a};
    hipError_t e = hipLaunchCooperativeKernel((const void*)hgswa_fwd, dim3(grid), dim3(512), kargs, LDS_BYTES, stream);
    if (e != hipSuccess) fprintf(stderr, "kernel_launch: cooperative launch failed: %s\n", hipGetErrorString(e));
#else
    for (int p = 0; p < 8; ++p) { a.ph_lo = p; a.ph_hi = p + 1; a.sync = 0;
        if (p == 1 || p == 3 || p == 6) { a.sub = 1; hipLaunchKernelGGL(hgswa_fwd, dim3(grid), dim3(512), LDS_BYTES, stream, a); a.sub = 2; hipLaunchKernelGGL(hgswa_fwd, dim3(grid), dim3(512), LDS_BYTES, stream, a); a.sub = 0; }
        else hipLaunchKernelGGL(hgswa_fwd, dim3(grid), dim3(512), LDS_BYTES, stream, a); }
#endif
}
```

```cpp
#include <hip/hip_runtime.h>
#include <hip/hip_cooperative_groups.h>
#include <cstdio>
#include <cstdint>
namespace cg = cooperative_groups;

#ifndef MK_N_LAUNCHES
#define MK_N_LAUNCHES 1
#endif

#ifndef PROBE_PHASE
#define PROBE_PHASE -1
#endif
#ifndef PGPRIO
#define PGPRIO 1
#endif
#ifndef PGALIGN
#define PGALIGN true
#endif
#ifndef PGSP4
#define PGSP4 false
#endif
#ifndef PGSP2
#define PGSP2 true
#endif
#define LAS __attribute__((address_space(3)))
typedef unsigned short bf16_t;
typedef short bf16x8 __attribute__((ext_vector_type(8)));
typedef short s16x4 __attribute__((ext_vector_type(4)));
typedef float f32x2 __attribute__((ext_vector_type(2)));
typedef float f32x4 __attribute__((ext_vector_type(4)));
typedef float f32x16 __attribute__((ext_vector_type(16)));
typedef unsigned u32x2 __attribute__((ext_vector_type(2)));
typedef unsigned u32x4 __attribute__((ext_vector_type(4)));
typedef __bf16 bf16x2_t __attribute__((ext_vector_type(2)));

constexpr int D = 4096, BATCH = 4, SEQ = 2048, NMETA = 16, TP = SEQ + NMETA  , MPROMPT = BATCH * TP  , NS = 32, MV = MPROMPT + NS  , MP = 8448  ;
constexpr int N1 = 16384, N2 = 4096, N3 = 9216, N4 = 4096;
constexpr int LDK = 4096;
constexpr int MFULL = 8192;
constexpr int NCHUNK = TP / 16;
constexpr int WIN = 128;
constexpr float EPS = 1e-6f;

constexpr size_t KiB = 1024, MiB = 1u << 20;
constexpr size_t WS_CTL = 0, WS_SSQ1 = 64 * KiB, WS_SSQ2 = 136 * KiB, CTL_ZERO_BYTES = 256 * KiB;
constexpr size_t WS_RSTD0 = 256 * KiB, WS_LB = 320 * KiB, WS_BT = 336 * KiB;
constexpr size_t WS_EBL = 1 * MiB, WS_K3 = 10 * MiB, WS_V3 = 19 * MiB;
constexpr size_t WS_W1 = 28 * MiB, WS_W2 = 158 * MiB, WS_W3 = 191 * MiB, WS_W4 = 265 * MiB;
constexpr size_t WS_X1 = 298 * MiB, WS_B0 = 430 * MiB, BUFB = 68 * MiB, WS_SLAB = WS_B0 + 6 * BUFB  , WS_END = WS_SLAB + 32 * MiB;
constexpr size_t O_YP = 0, O_YS = 33554432, O_SP = O_YS + 131072, O_KP = O_SP + 2097152, O_VP = O_KP + 262144, O_SS = O_VP + 262144, O_KS = O_SS + 16777216, O_VS = O_KS + 2097152, O_END = O_VS + 2097152;

constexpr int LDS_BYTES = PGSP4 ? 163840 : 147456;
constexpr int MISC_OFF = 135168;

__device__ __forceinline__ int opaque_tid() { int t = threadIdx.x; asm volatile("" : "+v"(t)); return t; }
__device__ __forceinline__ unsigned pk2(float lo, float hi) { f32x2 v = {lo, hi}; bf16x2_t b = __builtin_convertvector(v, bf16x2_t); return __builtin_bit_cast(unsigned, b); }
__device__ __forceinline__ float bf_lo(unsigned w) { return __uint_as_float(w << 16); }
__device__ __forceinline__ float bf_hi(unsigned w) { return __uint_as_float(w & 0xffff0000u); }
__device__ __forceinline__ float bf1(bf16_t x) { return __uint_as_float(((unsigned)x) << 16); }
__device__ __forceinline__ float fexp(float x) { return __expf(x); }
__device__ __forceinline__ float frcp(float x) { return __builtin_amdgcn_rcpf(x); }
__device__ __forceinline__ float silu_f(float x) { return x * frcp(1.0f + fexp(-x)); }
template <int CTRL> __device__ __forceinline__ float dpp_f(float v) { return __int_as_float(__builtin_amdgcn_update_dpp(0, __float_as_int(v), CTRL, 0xf, 0xf, true)); }
__device__ __forceinline__ float row_scan16(float x) { x += dpp_f<0x111>(x); x += dpp_f<0x112>(x); x += dpp_f<0x114>(x); x += dpp_f<0x118>(x); return x; }
__device__ __forceinline__ float row_sum16(float x) { x += dpp_f<0x128>(x); x += dpp_f<0x124>(x); x += dpp_f<0x122>(x); x += dpp_f<0x121>(x); return x; }
__host__ __device__ __forceinline__ int perm32(int rho) { const int n = rho >> 4, i = rho & 15; return 8 * (i >> 2) + 4 * n + (i & 3); }
__device__ __forceinline__ const float* x0_row(const float* xp, const float* xs, const float* meta, int r) {
    if (r < MPROMPT) { const int b = r / TP, t = r - b * TP; return t < NMETA ? meta + (size_t)t * D : xp + ((size_t)b * SEQ + (t - NMETA)) * D; }
    if (r < MV) return xs + (size_t)(r - MPROMPT) * D;
    return nullptr;
}
__device__ __forceinline__ size_t hm_off(int r, int rb, int h) {
    if (rb < MPROMPT) { const int b = rb / TP; return ((size_t)(b * 32 + h) * TP + (r - b * TP)) * 128; }
    return ((size_t)BATCH * 32 * TP + (size_t)(r - MPROMPT) * 32 + h) * 128;
}
__device__ __forceinline__ float rstd_from_ssq(unsigned long long s) { return rsqrtf((float)((double)s * (1.0 / 4294967296.0)) * (1.0f / D) + EPS); }
__device__ __forceinline__ void ssq_add(unsigned long long* p, float ss) { atomicAdd(p, (unsigned long long)((double)ss * 4294967296.0)); }

#define XB_FIX(k) (4096 + 64 * (k))
__device__ __forceinline__ void fix_done(unsigned* bar, int k) {
    asm volatile("s_waitcnt vmcnt(0)" ::: "memory");
    __syncthreads();
    if (threadIdx.x == 0) { __builtin_amdgcn_fence(__ATOMIC_RELEASE, "agent"); asm volatile("s_waitcnt vmcnt(0)" ::: "memory"); (void)__hip_atomic_fetch_add(&bar[XB_FIX(k)], 1u, __ATOMIC_RELAXED, __HIP_MEMORY_SCOPE_AGENT); }
}
__device__ __forceinline__ void fix_spin(unsigned* ctr, unsigned G) {
    unsigned sp = 0;
    while (__hip_atomic_load(ctr, __ATOMIC_RELAXED, __HIP_MEMORY_SCOPE_AGENT) < G) { __builtin_amdgcn_s_sleep(1); if (++sp > (1u << 22)) break; }
    __builtin_amdgcn_fence(__ATOMIC_ACQUIRE, "agent");
    asm volatile("s_waitcnt vmcnt(0)" ::: "memory");
}
__device__ __forceinline__ void fix_wait_wg(unsigned* ctr, unsigned G) { if (threadIdx.x == 0) fix_spin(ctr, G); __syncthreads(); }
__device__ __forceinline__ void fix_wait_wave(unsigned* ctr, unsigned G) { fix_spin(ctr, G); }

namespace pg8 {
constexpr int BM = 256, BK = 64, HALF = 128, HTB = HALF * BK * 2, STAGE_BYTES = 8 * HTB, NXCD = 8, WGM = 8;
__host__ __device__ __forceinline__ int lds_byte(int r, int c) { const int st = (r >> 4) * 2 + (c >> 5), rr = r & 15, cc = c & 31, ob = rr * 64 + cc * 2; return st * 1024 + (ob ^ (((ob >> 9) & 1) << 5)); }
__host__ __device__ __forceinline__ void stage_rc(int b, int& R, int& C) { const int st = b / 1024, sb = b % 1024, swz = sb ^ (((sb >> 9) & 1) << 5); R = (st >> 1) * 16 + swz / 64; C = (st & 1) * 32 + (swz % 64) / 2; }
struct Unit { int pm, pn, k0, nk, part; };
struct Gemm { const bf16_t* A; const bf16_t* Bt; int M, N, K, ld; unsigned* gate; int gate_pm; int mlive; };
struct StaticOrder {
    int nM, nN, nwg, G, c;
    __host__ __device__ __forceinline__ void init(int M, int N, int G_, int c_) { nM = M / BM; nN = N / BM; nwg = nM * nN; G = G_; c = c_; }
    __host__ __device__ __forceinline__ bool tile(int i, int& pm, int& pn) const {
        const long L = (long)i * G + c; if (L >= nwg) { pm = 0; pn = 0; return false; }
        int wgid = (int)L; { const int q = nwg / NXCD, r = nwg % NXCD, xcd = wgid % NXCD, off = wgid / NXCD; wgid = (xcd < r ? xcd * (q + 1) : r * (q + 1) + (xcd - r) * q) + off; }
        const int nig = WGM * nN, gid = wgid / nig, fm = gid * WGM, gsz = (nM - fm) < WGM ? (nM - fm) : WGM;
        pm = fm + ((wgid % nig) % gsz); pn = (wgid % nig) / gsz; return true;
    }
    __host__ __device__ __forceinline__ bool next(int i, Unit& u) const { int pm, pn; const bool ok = tile(i, pm, pn); u.pm = pm; u.pn = pn; u.k0 = 0; u.nk = 64; u.part = -1; return ok; }
};
template <int KS, int COFF, int GS> struct TailOrder {
    StaticOrder so; int nfull, NT, pmt;
    __host__ __device__ __forceinline__ void init(int Mfull, int N, int G_, int c_) { so.init(Mfull, N, G_, c_); nfull = c_ < so.nwg ? (so.nwg - c_ + G_ - 1) / G_ : 0; NT = so.nN * KS; pmt = Mfull / BM; }
    __host__ __device__ __forceinline__ bool next(int i, Unit& u) const {
        int pm, pn, k0 = 0, nk = 64, part = -1; bool ok;
        if (i < nfull) ok = so.tile(i, pm, pn);
        else {
            const int gs = GS ? GS : so.G; int tc = so.c - COFF; if (tc < 0) tc += so.G;
            const int s = tc + (i - nfull) * gs; ok = (tc < gs) && (s < NT);
            pm = pmt; pn = s / KS; nk = 64 / KS; k0 = (s - pn * KS) * nk; part = s;
        }
        u.pm = pm; u.pn = pn; u.k0 = k0; u.nk = nk; u.part = part; return ok;
    }
};
template <class Epi, class Sched, bool ALIGN_EPI, bool SP2, class Bar, int ABLATE = 0>
__device__ __forceinline__ void gemm_phase(LAS unsigned char* lds, const Gemm g, const Sched& S, const Epi& E, float* slab, const Bar ubar, bool usync, int urounds) {
    const int tid = opaque_tid(), wid = __builtin_amdgcn_readfirstlane(tid >> 6), lane = tid & 63, wr = wid >> 2, wc = wid & 3, fr = lane & 15, fq = lane >> 4;
    constexpr int ld = LDK;
    unsigned voff[2];
#pragma unroll
    for (int i = 0; i < 2; ++i) { int R, C; stage_rc(tid * 16 + i * 8192, R, C); voff[i] = (unsigned)(R * ld + C) * 2u; }
    const unsigned kstep = (unsigned)(BK * 2), hstep = (unsigned)(HALF * ld * 2), tstep = 2u * hstep;
    const __amdgpu_buffer_rsrc_t rA = __builtin_amdgcn_make_buffer_rsrc((void*)g.A, 0, ABLATE == 5 ? 0 : (int)((unsigned)g.M * (unsigned)ld * 2u), 0x00020000);
    const __amdgpu_buffer_rsrc_t rB = __builtin_amdgcn_make_buffer_rsrc((void*)g.Bt, 0, ABLATE == 5 ? 0 : (int)((unsigned)g.N * (unsigned)ld * 2u), 0x00020000);
    const unsigned ldsm0 = __builtin_amdgcn_readfirstlane((unsigned)(size_t)lds + (unsigned)wid * 1024u);
    const int aoff = lds_byte(wr * 64 + fr, fq * 8), boff = lds_byte(wc * 32 + fr, fq * 8);
#define PG8_SA(b, h) (((b) * 2 + (h)) * HTB)
#define PG8_SB(b, h) ((4 + (b) * 2 + (h)) * HTB)
#define PG8_STAGE(bufoff, rs, so) do { if (ABLATE == 3) break; _Pragma("unroll") for (int _i = 0; _i < 2; ++_i) \
        asm volatile("s_add_u32 m0, %0, %4\n\ts_nop 0\n\tbuffer_load_dwordx4 %1, %2, %3 offen lds" :: "s"(ldsm0), "v"(voff[_i]), "s"(rs), "s"(so), "n"((bufoff) + _i * 8192) : "m0", "scc", "memory"); } while (0)
#define PG8_LDA(dst, b, h) do { if (ABLATE == 2) break; _Pragma("unroll") for (int m = 0; m < 4; ++m) _Pragma("unroll") for (int k = 0; k < 2; ++k) dst[m][k] = *(const LAS bf16x8*)(lds + PG8_SA(b, h) + aoff + m * 2048 + k * 1024); } while (0)
#define PG8_LDB(dst, b, h) do { if (ABLATE == 2) break; _Pragma("unroll") for (int n = 0; n < 2; ++n) _Pragma("unroll") for (int k = 0; k < 2; ++k) dst[n][k] = *(const LAS bf16x8*)(lds + PG8_SB(b, h) + boff + n * 2048 + k * 1024); } while (0)
#define PG8_MMA(ai, bj, At, Bt) do { if (ABLATE == 1 && (ai) == 1) break; if (ABLATE == 4) break; if (PGPRIO == 1) __builtin_amdgcn_s_setprio(1); _Pragma("unroll") for (int m = 0; m < 4; ++m) _Pragma("unroll") for (int n = 0; n < 2; ++n) _Pragma("unroll") for (int k = 0; k < 2; ++k) \
        acc[ai][bj][m][n] = __builtin_amdgcn_mfma_f32_16x16x32_bf16(Bt[n][k], At[m][k], acc[ai][bj][m][n], 0, 0, 0); if (PGPRIO == 1) __builtin_amdgcn_s_setprio(0); } while (0)
#define PG8_WAIT_V(n) asm volatile("s_waitcnt vmcnt(" #n ")" ::: "memory")
#define PG8_WAIT_L(n) asm volatile("s_waitcnt lgkmcnt(" #n ")" ::: "memory")
#define PG8_BAR __builtin_amdgcn_s_barrier()
#define PG8_SCHED __builtin_amdgcn_sched_barrier(0)
    Unit cur, nxt; int ui = 0;
    if (!S.next(0, cur)) { if (usync) for (int r_ = 0; r_ < urounds; ++r_) ubar.sync(); return; }
    bool gated = false;
    if (g.gate && cur.pm >= g.gate_pm) { fix_wait_wg(g.gate, gridDim.x); gated = true; }
    f32x4 acc[2][2][4][2];
#pragma unroll
    for (int a = 0; a < 2; ++a)
#pragma unroll
        for (int b = 0; b < 2; ++b)
#pragma unroll
            for (int m = 0; m < 4; ++m)
#pragma unroll
                for (int n = 0; n < 2; ++n) acc[a][b][m][n] = (f32x4){0.f, 0.f, 0.f, 0.f};
    bf16x8 At[4][2], B0[2][2], B1[2][2];
    unsigned cA = (unsigned)cur.pm * tstep + (unsigned)cur.k0 * kstep, cB = (unsigned)cur.pn * tstep + (unsigned)cur.k0 * kstep;
    if constexpr (PGSP4) {
    bf16x8 At1[4][2];
    const int oth = 1 - wr;
    const unsigned ldsm0A = __builtin_amdgcn_readfirstlane((unsigned)(size_t)lds + (unsigned)oth * 8192u + (unsigned)(wid & 3) * 2048u);
    unsigned vl; { int R, C; stage_rc(lane * 16, R, C); vl = (unsigned)(R * ld + C) * 2u; }
    const unsigned cwA = (unsigned)((oth * 4 + (wid & 3)) * 16) * (unsigned)(ld * 2), cwB = (unsigned)((wid >> 1) * 16) * (unsigned)(ld * 2) + (unsigned)(wid & 1) * 64u;
    cA += cwA; cB += cwB;
#define PG8_DMA2(m0base, imm, vo, rs, so, soimm) do { unsigned _t; asm volatile("s_add_u32 m0, %1, %5\n\ts_add_u32 %0, %4, %6\n\tbuffer_load_dwordx4 %2, %3, %0 offen lds" : "=&s"(_t) : "s"(m0base), "v"(vo), "s"(rs), "s"(so), "n"(imm), "n"(soimm) : "m0", "scc", "memory"); } while (0)
#define PG8_DAP(ma, h, i, pa) do { if (ABLATE != 3) PG8_DMA2(ma, (h) * HTB + (i) * 1024, vl, rA, (pa), (h) * (HALF * LDK * 2) + (i) * 64); } while (0)
#define PG8_DBR(mb, h, i, pb) do { if (ABLATE != 3) PG8_DMA2(mb, (h) * HTB + (i) * 8192, vl, rB, (pb), (h) * (HALF * LDK * 2) + (i) * (64 * LDK * 2)); } while (0)
#define PG8_STAGE_AP(abuf, pa) do { const unsigned _m = ldsm0A + (abuf), _p = (pa); PG8_DAP(_m, 0, 0, _p); PG8_DAP(_m, 0, 1, _p); PG8_DAP(_m, 1, 0, _p); PG8_DAP(_m, 1, 1, _p); } while (0)
#define PG8_STAGE_BR(slot, pb) do { const unsigned _m = ldsm0 + (slot), _p = (pb); PG8_DBR(_m, 0, 0, _p); PG8_DBR(_m, 0, 1, _p); PG8_DBR(_m, 1, 0, _p); PG8_DBR(_m, 1, 1, _p); } while (0)
#define PG8_LDBR(dst, bb, h) do { if (ABLATE == 2) break; _Pragma("unroll") for (int n = 0; n < 2; ++n) _Pragma("unroll") for (int k = 0; k < 2; ++k) dst[n][k] = *(const LAS bf16x8*)((bb) + (h) * HTB + n * 2048 + k * 1024); } while (0)
#define PG8_LOAD4(b, slot) do { const LAS unsigned char* _bb = lds + (slot) + boff; PG8_LDBR(B0, _bb, 0); PG8_LDBR(B1, _bb, 1); PG8_LDA(At, b, 0); PG8_LDA(At1, b, 1); } while (0)
#define PG8_PINB() asm volatile("" : "+v"(B0[0][0]), "+v"(B0[0][1]), "+v"(B0[1][0]), "+v"(B0[1][1]), "+v"(B1[0][0]), "+v"(B1[0][1]), "+v"(B1[1][0]), "+v"(B1[1][1]))
#define PG8_PINC1(a, b) asm volatile("" : "+v"(acc[a][b][0][0]), "+v"(acc[a][b][0][1]), "+v"(acc[a][b][1][0]), "+v"(acc[a][b][1][1]), "+v"(acc[a][b][2][0]), "+v"(acc[a][b][2][1]), "+v"(acc[a][b][3][0]), "+v"(acc[a][b][3][1]))
#define PG8_PINC() do { PG8_PINC1(0, 0); PG8_PINC1(0, 1); PG8_PINC1(1, 0); PG8_PINC1(1, 1); } while (0)
#define PG8_MMA4() do { PG8_PINB(); if (PGPRIO == 2) __builtin_amdgcn_s_setprio(1); PG8_MMA(0, 0, At, B0); PG8_MMA(0, 1, At, B1); PG8_MMA(1, 0, At1, B0); PG8_MMA(1, 1, At1, B1); if (PGPRIO == 2) __builtin_amdgcn_s_setprio(0); PG8_PINC(); } while (0)
    unsigned r0 = 4u * HTB, r1 = 6u * HTB, r2 = 8u * HTB;
    PG8_STAGE_AP(PG8_SA(0, 0), cA); if (wr == 1) PG8_STAGE_AP(PG8_SA(1, 0), cA + kstep); PG8_STAGE_BR(r0, cB); PG8_STAGE_BR(r1, cB + kstep);
    PG8_WAIT_V(0);
    PG8_BAR;
    if (wr == 1) PG8_BAR;
    for (;;) {
        const bool has_next = S.next(ui + 1, nxt);
        if (g.gate && !gated && has_next && nxt.pm >= g.gate_pm) { fix_wait_wg(g.gate, gridDim.x); gated = true; }
        const unsigned nA = has_next ? (unsigned)nxt.pm * tstep + (unsigned)nxt.k0 * kstep + cwA : cA, nB = has_next ? (unsigned)nxt.pn * tstep + (unsigned)nxt.k0 * kstep + cwB : cB;
        int nt = cur.nk; asm volatile("" : "+s"(nt));
        __builtin_amdgcn_s_waitcnt(0x0F70);
        for (int t = 0; t < nt; t += 2) {
            const unsigned dA = (t + 2 < nt) ? cA + (unsigned)(t + 2) * kstep : nA + (unsigned)(t + 2 - nt) * kstep;
            const unsigned dB = (t + 2 < nt) ? cB + (unsigned)(t + 2) * kstep : nB + (unsigned)(t + 2 - nt) * kstep;
            PG8_LOAD4(0, r0);
            { const unsigned ab = wr ? (unsigned)PG8_SA(0, 0) : (unsigned)PG8_SA(1, 0), pa = wr ? dA : cA + (unsigned)(t + 1) * kstep; PG8_STAGE_AP(ab, pa); PG8_STAGE_BR(r2, dB); }
            PG8_WAIT_L(0); PG8_WAIT_V(8); PG8_BAR;
            PG8_MMA4(); PG8_BAR; PG8_SCHED;
            PG8_LOAD4(1, r1);
            { const unsigned ab = wr ? (unsigned)PG8_SA(1, 0) : (unsigned)PG8_SA(0, 0), pa = wr ? dA + kstep : dA; PG8_STAGE_AP(ab, pa); PG8_STAGE_BR(r0, dB + kstep); }
            PG8_WAIT_L(0); PG8_WAIT_V(8); PG8_BAR;
            PG8_MMA4(); PG8_BAR; PG8_SCHED;
            { const unsigned q = r0; r0 = r2; r2 = r1; r1 = q; }
        }
        if constexpr (ALIGN_EPI) { if (wr == 0) PG8_BAR; }
        const int tid2 = opaque_tid(), lane2 = tid2 & 63, wid2 = __builtin_amdgcn_readfirstlane(tid2 >> 6), wr2 = wid2 >> 2, wc2 = wid2 & 3, fr2 = lane2 & 15, fq2 = lane2 >> 4;
        if (cur.part >= 0) {
            float* sp = slab + ((size_t)cur.part * 16 * 512 + tid2) * 4;
#pragma unroll
            for (int bj = 0; bj < 2; ++bj)
#pragma unroll
                for (int m = 0; m < 4; ++m)
#pragma unroll
                    for (int n = 0; n < 2; ++n) *(f32x4*)(sp + (size_t)((bj * 4 + m) * 2 + n) * 512 * 4) = acc[0][bj][m][n];
        } else {
#pragma unroll
            for (int ai = 0; ai < 2; ++ai) {
                typename Epi::Pre pr[4];
#pragma unroll
                for (int m = 0; m < 4; ++m) pr[m] = E.pre(cur, ai, m, wr2, wc2, fr2, fq2);
                E.settle(pr);
#pragma unroll
                for (int m = 0; m < 4; ++m) { const f32x4 a4[2][2] = {{acc[ai][0][m][0], acc[ai][0][m][1]}, {acc[ai][1][m][0], acc[ai][1][m][1]}}; E.rows(a4, pr[m], cur, ai, m, wr2, wc2, fr2, fq2); }
            }
        }
        if (usync) ubar.sync();
        if (!has_next) break;
#pragma unroll
        for (int a = 0; a < 2; ++a)
#pragma unroll
            for (int b = 0; b < 2; ++b)
#pragma unroll
                for (int m = 0; m < 4; ++m)
#pragma unroll
                    for (int n = 0; n < 2; ++n) acc[a][b][m][n] = (f32x4){0.f, 0.f, 0.f, 0.f};
        cur = nxt; cA = nA; cB = nB; ++ui;
        if constexpr (ALIGN_EPI) { if (wr == 1) PG8_BAR; }
    }
    PG8_WAIT_V(0);
    if constexpr (!ALIGN_EPI) { if (wr == 0) PG8_BAR; }
    PG8_BAR;
    if (usync) for (int r_ = ui + 1; r_ < urounds; ++r_) ubar.sync();
#undef PG8_DMA2
#undef PG8_STAGE_AP
#undef PG8_STAGE_BR
#undef PG8_LDBR
#undef PG8_LOAD4
#undef PG8_MMA4
#undef PG8_PINB
#undef PG8_PINC1
#undef PG8_PINC
#undef PG8_DAP
#undef PG8_DBR
    } else {
    if constexpr (SP2) {
        PG8_STAGE(PG8_SB(0, 0), rB, cB); PG8_STAGE(PG8_SB(0, 1), rB, cB + hstep); PG8_STAGE(PG8_SA(0, 0), rA, cA); PG8_STAGE(PG8_SA(0, 1), rA, cA + hstep);
        if (wr == 1) PG8_BAR;
        PG8_WAIT_V(2); PG8_BAR;
        PG8_STAGE(PG8_SB(1, 0), rB, cB + kstep); PG8_STAGE(PG8_SA(1, 0), rA, cA + kstep); PG8_STAGE(PG8_SB(1, 1), rB, cB + hstep + kstep);
        PG8_WAIT_V(6); PG8_BAR;
    } else {
        PG8_STAGE(PG8_SB(0, 0), rB, cB); PG8_STAGE(PG8_SA(0, 0), rA, cA); PG8_STAGE(PG8_SB(0, 1), rB, cB + hstep); PG8_STAGE(PG8_SA(0, 1), rA, cA + hstep);
        if (wr == 1) PG8_BAR;
        PG8_WAIT_V(4); PG8_BAR;
        PG8_STAGE(PG8_SB(1, 0), rB, cB + kstep); PG8_STAGE(PG8_SA(1, 0), rA, cA + kstep); PG8_STAGE(PG8_SB(1, 1), rB, cB + hstep + kstep);
        PG8_WAIT_V(6); PG8_BAR;
    }
    for (;;) {
        const bool has_next = S.next(ui + 1, nxt);
        if (g.gate && !gated && has_next && nxt.pm >= g.gate_pm) { fix_wait_wg(g.gate, gridDim.x); gated = true; }
        const unsigned nA = has_next ? (unsigned)nxt.pm * tstep + (unsigned)nxt.k0 * kstep : cA, nB = has_next ? (unsigned)nxt.pn * tstep + (unsigned)nxt.k0 * kstep : cB;
        const bool tailu = cur.part >= 0 || (g.mlive > 0 && cur.pm * BM + HALF >= g.mlive);
        const int nt = cur.nk;
#define PG8_SP2_BODY(SKIP1) \
            const bool last = (t == nt - 2); \
            const unsigned a1 = cA + (unsigned)(t + 1) * kstep; \
            const unsigned a2 = last ? nA : cA + (unsigned)(t + 2) * kstep, b2 = last ? nB : cB + (unsigned)(t + 2) * kstep; \
            const unsigned a3 = a2 + kstep, b3 = b2 + kstep; \
            PG8_LDB(B0, 0, 0); PG8_LDB(B1, 0, 1); PG8_SCHED; PG8_LDA(At, 0, 0); PG8_STAGE(PG8_SA(1, 1), rA, a1 + hstep); \
            PG8_WAIT_V(8); PG8_WAIT_L(0); PG8_BAR; PG8_MMA(0, 0, At, B0); PG8_MMA(0, 1, At, B1); PG8_BAR; PG8_SCHED; \
            if (!(SKIP1)) PG8_LDA(At, 0, 1); PG8_STAGE(PG8_SB(0, 0), rB, b2); PG8_STAGE(PG8_SB(0, 1), rB, b2 + hstep); PG8_STAGE(PG8_SA(0, 0), rA, a2); \
            PG8_WAIT_V(8); PG8_WAIT_L(0); PG8_BAR; if (!(SKIP1)) { PG8_MMA(1, 0, At, B0); PG8_MMA(1, 1, At, B1); } PG8_BAR; PG8_SCHED; \
            PG8_LDB(B0, 1, 0); PG8_LDB(B1, 1, 1); PG8_SCHED; PG8_LDA(At, 1, 0); PG8_STAGE(PG8_SA(0, 1), rA, a2 + hstep); \
            PG8_WAIT_V(8); PG8_WAIT_L(0); PG8_BAR; PG8_MMA(0, 0, At, B0); PG8_MMA(0, 1, At, B1); PG8_BAR; PG8_SCHED; \
            if (!(SKIP1)) PG8_LDA(At, 1, 1); PG8_STAGE(PG8_SB(1, 0), rB, b3); PG8_STAGE(PG8_SB(1, 1), rB, b3 + hstep); PG8_STAGE(PG8_SA(1, 0), rA, a3); \
            PG8_WAIT_V(8); PG8_WAIT_L(0); PG8_BAR; if (!(SKIP1)) { PG8_MMA(1, 0, At, B0); PG8_MMA(1, 1, At, B1); } PG8_BAR; PG8_SCHED;
        if (SP2 && tailu) { for (int t = 0; t < nt; t += 2) { PG8_SP2_BODY(true) } }
        else
        for (int t = 0; t < nt; t += 2) {
            if constexpr (SP2) { PG8_SP2_BODY(false)
            } else {
            const bool last = (t == nt - 2);
            const unsigned a1 = cA + (unsigned)(t + 1) * kstep;
            const unsigned a2 = last ? nA : cA + (unsigned)(t + 2) * kstep, b2 = last ? nB : cB + (unsigned)(t + 2) * kstep;
            const unsigned a3 = a2 + kstep, b3 = b2 + kstep;
            PG8_LDB(B0, 0, 0); PG8_SCHED; PG8_LDA(At, 0, 0); PG8_STAGE(PG8_SA(1, 1), rA, a1 + hstep);
            PG8_WAIT_L(8); PG8_BAR; PG8_WAIT_L(0); PG8_MMA(0, 0, At, B0); PG8_BAR; PG8_SCHED;
            PG8_LDB(B1, 0, 1); PG8_STAGE(PG8_SB(0, 0), rB, b2);
            PG8_BAR; PG8_WAIT_L(0); PG8_MMA(0, 1, At, B1); PG8_BAR;
            PG8_LDA(At, 0, 1); PG8_STAGE(PG8_SA(0, 0), rA, a2);
            PG8_BAR; PG8_WAIT_L(0); PG8_MMA(1, 0, At, B0); PG8_BAR; PG8_SCHED;
            PG8_STAGE(PG8_SB(0, 1), rB, b2 + hstep);
            PG8_WAIT_V(6); PG8_BAR; PG8_MMA(1, 1, At, B1); PG8_BAR;
            PG8_LDB(B0, 1, 0); PG8_SCHED; PG8_LDA(At, 1, 0); PG8_STAGE(PG8_SA(0, 1), rA, a2 + hstep);
            PG8_WAIT_L(8); PG8_BAR; PG8_WAIT_L(0); PG8_MMA(0, 0, At, B0); PG8_BAR; PG8_SCHED;
            PG8_LDB(B1, 1, 1); PG8_STAGE(PG8_SB(1, 0), rB, b3);
            PG8_BAR; PG8_WAIT_L(0); PG8_MMA(0, 1, At, B1); PG8_BAR;
            PG8_LDA(At, 1, 1); PG8_STAGE(PG8_SA(1, 0), rA, a3);
            PG8_BAR; PG8_WAIT_L(0); PG8_MMA(1, 0, At, B0); PG8_BAR; PG8_SCHED;
            PG8_STAGE(PG8_SB(1, 1), rB, b3 + hstep);
            PG8_WAIT_V(6); PG8_BAR; PG8_MMA(1, 1, At, B1); PG8_BAR;
            }
        }
        if constexpr (ALIGN_EPI) { if (wr == 0) PG8_BAR; }
        const int tid2 = opaque_tid(), lane2 = tid2 & 63, wid2 = __builtin_amdgcn_readfirstlane(tid2 >> 6), wr2 = wid2 >> 2, wc2 = wid2 & 3, fr2 = lane2 & 15, fq2 = lane2 >> 4;
        if (cur.part >= 0) {
            float* sp = slab + ((size_t)cur.part * 16 * 512 + tid2) * 4;
#pragma unroll
            for (int bj = 0; bj < 2; ++bj)
#pragma unroll
                for (int m = 0; m < 4; ++m)
#pragma unroll
                    for (int n = 0; n < 2; ++n) *(f32x4*)(sp + (size_t)((bj * 4 + m) * 2 + n) * 512 * 4) = acc[0][bj][m][n];
        } else {
#pragma unroll
            for (int ai = 0; ai < 2; ++ai) {
                if (ai == 1 && tailu) break;
                typename Epi::Pre pr[4];
#pragma unroll
                for (int m = 0; m < 4; ++m) pr[m] = E.pre(cur, ai, m, wr2, wc2, fr2, fq2);
                E.settle(pr);
#pragma unroll
                for (int m = 0; m < 4; ++m) { const f32x4 a4[2][2] = {{acc[ai][0][m][0], acc[ai][0][m][1]}, {acc[ai][1][m][0], acc[ai][1][m][1]}}; E.rows(a4, pr[m], cur, ai, m, wr2, wc2, fr2, fq2); }
            }
        }
        if (usync) ubar.sync();
        if (!has_next) break;
#pragma unroll
        for (int a = 0; a < 2; ++a)
#pragma unroll
            for (int b = 0; b < 2; ++b)
#pragma unroll
                for (int m = 0; m < 4; ++m)
#pragma unroll
                    for (int n = 0; n < 2; ++n) acc[a][b][m][n] = (f32x4){0.f, 0.f, 0.f, 0.f};
        cur = nxt; cA = nA; cB = nB; ++ui;
        if constexpr (ALIGN_EPI) { if (wr == 1) PG8_BAR; }
    }
    PG8_WAIT_V(0);
    if constexpr (!ALIGN_EPI) { if (wr == 0) PG8_BAR; }
    PG8_BAR;
    if (usync) for (int r_ = ui + 1; r_ < urounds; ++r_) ubar.sync();
    }
#undef PG8_SA
#undef PG8_SB
#undef PG8_STAGE
#undef PG8_LDA
#undef PG8_LDB
#undef PG8_MMA
#undef PG8_WAIT_V
#undef PG8_WAIT_L
#undef PG8_BAR
#undef PG8_SCHED
}
template <int KS, class Epi> __device__ __forceinline__ void gemm_tail_fixup(const float* slab, int nN, int pmt, int G, int c, const Epi& E, int c0 = 0, int nw = 0) {
    const int tid = opaque_tid(), wid = __builtin_amdgcn_readfirstlane(tid >> 6), lane = tid & 63, wr = wid >> 2, wc = wid & 3, fr = lane & 15, fq = lane >> 4;
    if (nw <= 0) { nw = G; c0 = 0; }
    int cc = c - c0; if (cc < 0) cc += G;
    if (cc >= nw) return;
    for (int pc = cc; pc < nN * 4; pc += nw) {
        const int pn = pc >> 2, m = pc & 3;
        f32x4 t[2][2];
#pragma unroll
        for (int bj = 0; bj < 2; ++bj)
#pragma unroll
            for (int n = 0; n < 2; ++n) t[bj][n] = (f32x4){0.f, 0.f, 0.f, 0.f};
#pragma unroll 4
        for (int ks = 0; ks < KS; ++ks) {
            const float* sp = slab + ((size_t)(pn * KS + ks) * 16 * 512 + tid) * 4;
#pragma unroll
            for (int bj = 0; bj < 2; ++bj)
#pragma unroll
                for (int n = 0; n < 2; ++n) t[bj][n] += *(const f32x4*)(sp + (size_t)((bj * 4 + m) * 2 + n) * 512 * 4);
        }
        Unit u; u.pm = pmt; u.pn = pn; u.k0 = 0; u.nk = 64; u.part = -1;
        E.rows(t, E.pre(u, 0, m, wr, wc, fr, fq), u, 0, m, wr, wc, fr, fq);
    }
}
}

typedef const f32x4 (&Acc4)[2][2];
__device__ __forceinline__ u32x4 pack8(const f32x4& a, const f32x4& b) { u32x4 w; w.x = pk2(a[0], a[1]); w.y = pk2(a[2], a[3]); w.z = pk2(b[0], b[1]); w.w = pk2(b[2], b[3]); return w; }

struct EpiHg {
    bf16_t *QT, *KT, *KD, *V, *SG; float* EBL; const float* RSTD0; const float* LB;
    struct Pre { float rs; f32x4 l0, l1; };
    __device__ __forceinline__ Pre pre(const pg8::Unit& u, int ai, int m, int wr, int wc, int fr, int fq) const {
        Pre p; p.rs = RSTD0[u.pm * 256 + ai * 128 + wr * 64 + m * 16 + fr];
        const int col = (u.pn < 32 ? u.pn * 128 : 0) + wc * 32 + 8 * fq; p.l0 = *(const f32x4*)(LB + col); p.l1 = *(const f32x4*)(LB + col + 4); return p; }
    __device__ __forceinline__ void settle(Pre (&p)[4]) const {
#pragma unroll
        for (int m = 0; m < 4; ++m) asm volatile("" : "+v"(p[m].rs), "+v"(p[m].l0), "+v"(p[m].l1)); }
    __device__ __forceinline__ void rows(Acc4 a, const Pre& pr, const pg8::Unit& u, int ai, int m, int wr, int wc, int fr, int fq) const {
        const int pn = u.pn, r = u.pm * 256 + ai * 128 + wr * 64 + m * 16 + fr; const float rs = pr.rs;
        if (pn < 32) {
            const f32x4 l0 = pr.l0, l1 = pr.l1;
            const float lbv[8] = {l0[0], l0[1], l0[2], l0[3], l1[0], l1[1], l1[2], l1[3]};
            const bool prompt = (r - fr) < MPROMPT;
            float qo[8], ko[8], eb8[8], lg[8];
#pragma unroll
            for (int n = 0; n < 2; ++n)
#pragma unroll
                for (int j = 0; j < 4; ++j) {
                    const int ix = 4 * n + j;
                    const float q = a[0][n][j] * rs; float f = a[1][n][j] * rs;
                    f = fminf(fmaxf(f, -60.f), 60.f);
                    const float e = fexp(-f), sig = frcp(1.0f + e), oms = e * sig, oml = 1.0f - lbv[ix];
                    const float fg = lbv[ix] + oml * sig;
                    qo[ix] = silu_f(q); ko[ix] = oml * oms; lg[ix] = fg; eb8[ix] = 0.f;
                }
            if (prompt) {
#pragma unroll
                for (int ix = 0; ix < 8; ++ix) lg[ix] = __builtin_amdgcn_logf(lg[ix]);
#pragma unroll
                for (int ix = 0; ix < 8; ++ix) lg[ix] += dpp_f<0x111>(lg[ix]);
#pragma unroll
                for (int ix = 0; ix < 8; ++ix) lg[ix] += dpp_f<0x112>(lg[ix]);
#pragma unroll
                for (int ix = 0; ix < 8; ++ix) lg[ix] += dpp_f<0x114>(lg[ix]);
#pragma unroll
                for (int ix = 0; ix < 8; ++ix) lg[ix] += dpp_f<0x118>(lg[ix]);
#pragma unroll
                for (int ix = 0; ix < 8; ++ix) { const float ebc = __builtin_amdgcn_exp2f(lg[ix]), ieb = __builtin_amdgcn_exp2f(-lg[ix]);
                    qo[ix] *= ebc; ko[ix] *= ieb; eb8[ix] = ebc; }
            }
            const size_t o = hm_off(r, r - fr, pn) + wc * 32 + 8 * fq;
            u32x4 w; w.x = pk2(qo[0], qo[1]); w.y = pk2(qo[2], qo[3]); w.z = pk2(qo[4], qo[5]); w.w = pk2(qo[6], qo[7]); __builtin_nontemporal_store(w, (u32x4*)(QT + o));
            w.x = pk2(ko[0], ko[1]); w.y = pk2(ko[2], ko[3]); w.z = pk2(ko[4], ko[5]); w.w = pk2(ko[6], ko[7]); __builtin_nontemporal_store(w, (u32x4*)(KT + o));
            if (prompt && fr == 15) { const int b = r / TP; float* ep = EBL + ((size_t)(b * 32 + pn) * NCHUNK + ((r - b * TP) >> 4)) * 128 + wc * 32 + 8 * fq; *(f32x4*)ep = (f32x4){eb8[0], eb8[1], eb8[2], eb8[3]}; *(f32x4*)(ep + 4) = (f32x4){eb8[4], eb8[5], eb8[6], eb8[7]}; }
        } else {
            const bool isg = pn >= 48; bf16_t* dst = isg ? SG : V;
            const int h0 = (pn - (isg ? 48 : 32)) * 2;
#pragma unroll
            for (int bj = 0; bj < 2; ++bj) {
                f32x4 v0 = a[bj][0] * rs, v1 = a[bj][1] * rs;
                if (isg) {
#pragma unroll
                    for (int j = 0; j < 4; ++j) { v0[j] = silu_f(v0[j]); v1[j] = silu_f(v1[j]); } }
                __builtin_nontemporal_store(pack8(v0, v1), (u32x4*)(dst + hm_off(r, r - fr, h0 + bj) + wc * 32 + 8 * fq));
            }
        }
    }
};
struct EpiRes {
    const bf16_t* XI; bf16_t* XO; unsigned long long* SSQ;
    struct Pre { u32x4 x[2]; };
    __device__ __forceinline__ Pre pre(const pg8::Unit& u, int ai, int m, int wr, int wc, int fr, int fq) const {
        const int col0 = u.pn * 256 + wc * 32 + 8 * fq, r = u.pm * 256 + ai * 128 + wr * 64 + m * 16 + fr; Pre p;
#pragma unroll
        for (int bj = 0; bj < 2; ++bj) p.x[bj] = *(const u32x4*)(XI + (size_t)r * LDK + col0 + bj * 128);
        return p; }
    __device__ __forceinline__ void settle(Pre (&p)[4]) const { asm volatile("" : "+v"(p[0].x[0]), "+v"(p[0].x[1]), "+v"(p[1].x[0]), "+v"(p[1].x[1]), "+v"(p[2].x[0]), "+v"(p[2].x[1]), "+v"(p[3].x[0]), "+v"(p[3].x[1])); }
    __device__ __forceinline__ void rows(Acc4 a, const Pre& pr, const pg8::Unit& u, int ai, int m, int wr, int wc, int fr, int fq) const {
        const int col0 = u.pn * 256 + wc * 32 + 8 * fq, r = u.pm * 256 + ai * 128 + wr * 64 + m * 16 + fr;
        float ss = 0.f;
#pragma unroll
        for (int bj = 0; bj < 2; ++bj) {
            const size_t o = (size_t)r * LDK + col0 + bj * 128;
            const u32x4 xw = pr.x[bj];
            const f32x4 a0 = {bf_lo(xw.x), bf_hi(xw.x), bf_lo(xw.y), bf_hi(xw.y)}, a1 = {bf_lo(xw.z), bf_hi(xw.z), bf_lo(xw.w), bf_hi(xw.w)};
            const f32x4 v0 = a[bj][0] + a0, v1 = a[bj][1] + a1;
            *(u32x4*)(XO + o) = pack8(v0, v1);
            ss += (v0[0] * v0[0] + v0[1] * v0[1]) + (v0[2] * v0[2] + v0[3] * v0[3]) + (v1[0] * v1[0] + v1[1] * v1[1]) + (v1[2] * v1[2] + v1[3] * v1[3]);
        }
        ss += __shfl_xor(ss, 16); ss += __shfl_xor(ss, 32);
        if (fq == 0) ssq_add(SSQ + r, ss);
    }
};
struct EpiSw {
    bf16_t *Q3, *K3, *V3, *SG3; const unsigned long long* SSQ;
    struct Pre { unsigned long long s; };
    __device__ __forceinline__ Pre pre(const pg8::Unit& u, int ai, int m, int wr, int wc, int fr, int fq) const { Pre p; p.s = SSQ[u.pm * 256 + ai * 128 + wr * 64 + m * 16 + fr]; return p; }
    __device__ __forceinline__ void settle(Pre (&p)[4]) const { asm volatile("" : "+v"(p[0].s), "+v"(p[1].s), "+v"(p[2].s), "+v"(p[3].s)); }
    __device__ __forceinline__ void rows(Acc4 a, const Pre& pr, const pg8::Unit& u, int ai, int m, int wr, int wc, int fr, int fq) const {
        const int pn = u.pn; bf16_t* dst; int ld, colt; float sc = 1.f; bool act = false;
        if (pn < 16) { dst = Q3; ld = D; colt = pn * 256; sc = 0.125f * 1.4426950408889634f; }
        else if (pn < 18) { dst = K3; ld = 512; colt = (pn - 16) * 256; }
        else if (pn < 20) { dst = V3; ld = 512; colt = (pn - 18) * 256; }
        else { dst = SG3; ld = D; colt = (pn - 20) * 256; act = true; }
        const int col0 = colt + wc * 32 + 8 * fq, r = u.pm * 256 + ai * 128 + wr * 64 + m * 16 + fr; const float rs = rstd_from_ssq(pr.s) * sc;
#pragma unroll
        for (int bj = 0; bj < 2; ++bj) {
            f32x4 v0 = a[bj][0] * rs, v1 = a[bj][1] * rs;
            if (act) {
#pragma unroll
                for (int j = 0; j < 4; ++j) { v0[j] = silu_f(v0[j]); v1[j] = silu_f(v1[j]); } }
            if (pn >= 16 && pn < 20) *(u32x4*)(dst + (size_t)r * ld + col0 + bj * 128) = pack8(v0, v1);
            else *(u32x4*)(dst + (size_t)r * ld + col0 + bj * 128) = pack8(v0, v1);
        }
    }
};

struct EpiDummy { float* out;
    struct Pre { int z; };
    __device__ __forceinline__ Pre pre(const pg8::Unit& u, int ai, int m, int wr, int wc, int fr, int fq) const { Pre p; p.z = 0; return p; }
    __device__ __forceinline__ void settle(Pre (&p)[4]) const {}
    __device__ __forceinline__ void rows(Acc4 a, const Pre& pr, const pg8::Unit& u, int ai, int m, int wr, int wc, int fr, int fq) const {
        *(f32x4*)(out + ((size_t)(blockIdx.x * 512 + threadIdx.x) * 8 + ai * 4 + m) * 4) = (a[0][0] + a[0][1]) + (a[1][0] + a[1][1]); }
};
struct Args { const float* in[17]; float* out; unsigned char* ws; int ph_lo, ph_hi, sync, sub; };
enum { I_XP = 0, I_XS, I_STATE, I_CK, I_CV, I_META, I_RELB, I_HGLB, I_HGNORM, I_HGWIN, I_HGONORM, I_HGWOUT, I_SWNORM, I_SWWIN, I_SWSINK, I_SWWOUT, I_FNORM };

constexpr int WSCR = 64 * 132;
__device__ __forceinline__ float wave_sum(float v) {
#pragma unroll
    for (int o = 1; o < 64; o <<= 1) v += __shfl_xor(v, o);
    return v;
}
struct WItem { const float* src; const float* scl; bf16_t* dst; int N; bool nt; };
constexpr int WC1 = N1 / 64, WC2 = N2 / 64, WC3 = N3 / 64, WC4 = N4 / 64, WCT = WC1 + WC2 + WC3 + WC4;
__device__ __forceinline__ WItem w_resolve(const Args& a, int cb, int kb, int lane) {
    unsigned char* ws = a.ws; const float* W; const float* scale; bf16_t* Wt; int N; bool qf = false, late = false;
    if (cb < WC1) { W = a.in[I_HGWIN]; N = N1; Wt = (bf16_t*)(ws + WS_W1); scale = a.in[I_HGNORM]; qf = true; }
    else if (cb < WC1 + WC2) { cb -= WC1; W = a.in[I_HGWOUT]; N = N2; Wt = (bf16_t*)(ws + WS_W2); scale = a.in[I_HGONORM]; }
    else if (cb < WC1 + WC2 + WC3) { cb -= WC1 + WC2; W = a.in[I_SWWIN]; N = N3; Wt = (bf16_t*)(ws + WS_W3); scale = a.in[I_SWNORM]; late = true; }
    else { cb -= WC1 + WC2 + WC3; W = a.in[I_SWWOUT]; N = N4; Wt = (bf16_t*)(ws + WS_W4); scale = nullptr; late = true; }
    const int ocb = cb * 64; int lcb = ocb;
    if (qf && ocb < 8192) lcb = ((ocb >> 7) & 31) * 256 + (ocb >> 12) * 128 + (ocb & 127);
    const int cgp = lane & 15, kq = lane >> 4;
    WItem it; it.N = N; it.nt = late;
    it.src = W + (size_t)(kb * 64 + 2 * kq) * N + ocb + 4 * cgp;
    it.scl = scale ? scale + kb * 64 + 2 * kq : nullptr;
    it.dst = Wt + (size_t)lcb * LDK + kb * 64 + 8 * (lane & 7);
    return it;
}
__device__ __forceinline__ void w_load(const WItem& it, f32x4 (&v)[16], f32x2 (&sc)[8]) {
#pragma unroll
    for (int i = 0; i < 8; ++i) sc[i] = it.scl ? *(const f32x2*)(it.scl + 8 * i) : (f32x2){1.f, 1.f};
#pragma unroll
    for (int i = 0; i < 8; ++i) { v[2 * i] = __builtin_nontemporal_load((const f32x4*)(it.src + (size_t)(8 * i) * it.N)); v[2 * i + 1] = __builtin_nontemporal_load((const f32x4*)(it.src + (size_t)(8 * i + 1) * it.N)); }
}
__device__ __forceinline__ void w_finish(const WItem& it, const f32x4 (&v)[16], const f32x2 (&sc)[8], int lane, LAS unsigned char* scr) {
    const int cgp = lane & 15, kq = lane >> 4;
#pragma unroll
    for (int i = 0; i < 8; ++i) {
#pragma unroll
        for (int jj = 0; jj < 4; ++jj) *(LAS unsigned*)(scr + (4 * cgp + jj) * 132 + (8 * i + 2 * kq) * 2) = pk2(v[2 * i][jj] * sc[i].x, v[2 * i + 1][jj] * sc[i].y);
    }
#pragma unroll
    for (int j = 0; j < 8; ++j) {
        const int rr = (lane >> 3) + 8 * j, c = (rr & ~31) + perm32(rr & 31);
        LAS unsigned char* p = scr + c * 132 + (lane & 7) * 16;
        u32x4 w; w.x = *(LAS unsigned*)p; w.y = *(LAS unsigned*)(p + 4); w.z = *(LAS unsigned*)(p + 8); w.w = *(LAS unsigned*)(p + 12);
        if (it.nt) __builtin_nontemporal_store(w, (u32x4*)(it.dst + (size_t)rr * LDK)); else *(u32x4*)(it.dst + (size_t)rr * LDK) = w;
    }
}
__device__ __forceinline__ void w_convert1(const Args& a, int first, int end, int step, int ncb, int cb0, int lane, LAS unsigned char* scr) {
    for (int it = first; it < end; it += step) {
        f32x4 va[16]; f32x2 sa[8];
        const int kba = it / ncb; const WItem A = w_resolve(a, cb0 + (it - kba * ncb), kba, lane);
        w_load(A, va, sa); w_finish(A, va, sa, lane, scr);
    }
}
__device__ __forceinline__ void w_convert(const Args& a, int first, int end, int step, int ncb, int cb0, int lane, LAS unsigned char* scr) {
    for (int it = first; it < end; it += 2 * step) {
        f32x4 va[16], vb[16]; f32x2 sa[8], sb[8];
        const int kba = it / ncb; const WItem A = w_resolve(a, cb0 + (it - kba * ncb), kba, lane);
        w_load(A, va, sa);
        const int it2 = it + step; const bool hasB = it2 < end;
        const int kbb = hasB ? it2 / ncb : kba; const WItem B = w_resolve(a, cb0 + (hasB ? it2 - kbb * ncb : it - kba * ncb), kbb, lane);
        if (hasB) w_load(B, vb, sb);
        w_finish(A, va, sa, lane, scr);
        if (hasB) w_finish(B, vb, sb, lane, scr);
    }
}
__device__ __forceinline__ void p0_prep(const Args& a, int G, LAS unsigned char* lds) {
    const int tid = opaque_tid(), lane = tid & 63, wave = tid >> 6;
    const int gw = blockIdx.x * 8 + wave, NGW = G * 8;
    unsigned char* ws = a.ws;
    {   const int CT = (G == 256) ? WC1 : WCT;
        LAS unsigned char* scr = lds + wave * WSCR;
        w_convert(a, gw, CT * 64, NGW, CT, 0, lane, scr);
    }
    bf16_t* XB0 = (bf16_t*)(ws + WS_B0); float* RSTD0 = (float*)(ws + WS_RSTD0);
    {   const int r0 = gw, rstep = NGW;
        for (int r = r0; r < MP; r += rstep) {
            const float* src = x0_row(a.in[I_XP], a.in[I_XS], a.in[I_META], r);
            bf16_t* dst = XB0 + (size_t)r * LDK;
            if (!src) { for (int j = 0; j < 8; ++j) *(u32x4*)(dst + j * 512 + lane * 8) = (u32x4){0u, 0u, 0u, 0u}; if (lane == 0) RSTD0[r] = 0.f; continue; }
            float ss = 0.f;
            f32x4 xv[16];
#pragma unroll
            for (int j = 0; j < 8; ++j) { xv[2 * j] = __builtin_nontemporal_load((const f32x4*)(src + j * 512 + lane * 8)); xv[2 * j + 1] = __builtin_nontemporal_load((const f32x4*)(src + j * 512 + lane * 8 + 4)); }
#pragma unroll
            for (int j = 0; j < 8; ++j) {
                const f32x4 v0 = xv[2 * j], v1 = xv[2 * j + 1];
                ss += (v0[0] * v0[0] + v0[1] * v0[1]) + (v0[2] * v0[2] + v0[3] * v0[3]) + (v1[0] * v1[0] + v1[1] * v1[1]) + (v1[2] * v1[2] + v1[3] * v1[3]);
                *(u32x4*)(dst + j * 512 + lane * 8) = pack8(v0, v1);
            }
            ss = wave_sum(ss);
            if (lane == 0) RSTD0[r] = rsqrtf(ss * (1.0f / D) + EPS);
        }
    }
    const int gt = blockIdx.x * 512 + tid, NGT = G * 512;
    float* LB = (float*)(ws + WS_LB); float* BT = (float*)(ws + WS_BT);
    for (int i = gt; i < D; i += NGT) {
        const float x0 = a.in[I_HGLB][i], x1 = a.in[I_HGLB][D + i], x2 = a.in[I_HGLB][2 * D + i];
        const float mx = fmaxf(x0, fmaxf(x1, x2)); const float e0 = expf(x0 - mx), e1 = expf(x1 - mx), e2 = expf(x2 - mx);
        LB[i] = e0 / (e0 + e1 + e2);
    }
    for (int i = gt; i < 64 * 129; i += NGT) {
        const int h = i / 129, dist = i - h * 129; int bucket;
        if (dist < 16) bucket = dist;
        else { const float dd = (float)dist; int large = 16 + (int)(logf(dd / 16.0f) / 2.0794415416798357f * 16.0f); bucket = large < 31 ? large : 31; }
        BT[h * 132 + dist] = a.in[I_RELB][bucket * 64 + h] * 1.4426950408889634f;
    }
}

__device__ __forceinline__ s16x4 ds_tr16(LAS unsigned char* p) { return __builtin_bit_cast(s16x4, __builtin_amdgcn_ds_read_tr16_b64_v4i16((LAS s16x4*)p)); }
__device__ __forceinline__ bf16x8 mk8(u32x2 lo, u32x2 hi) { u32x4 w = {lo.x, lo.y, hi.x, hi.y}; return __builtin_bit_cast(bf16x8, w); }
__device__ __forceinline__ bf16x8 mk8z(s16x4 t) { bf16x8 r = {t[0], t[1], t[2], t[3], 0, 0, 0, 0}; return r; }

struct HgRegs { u32x2 q0, k0, v0, sg0, q1, k1, v1, sg1; f32x4 e0, e1; };
struct HgCtx { const char *QT, *KT, *V, *SG, *EB; char* A2; unsigned toff, eoff, aoff; int tid, w, lv, g, srow, sseg; };
constexpr int HG_NSTEP = (NCHUNK + 1) / 2;
constexpr int HG_RS = 272, HG_RN = 288, HG_TILE = 16 * HG_RN;
constexpr int HG_BUF = 10 * HG_TILE + 512, HG_OB_OFF = 2 * HG_BUF, HG_OROW = 132 * 4, HG_OBUF = 32 * HG_OROW, HG_SQ_OFF = HG_OB_OFF + 2 * HG_OBUF;
static_assert(HG_SQ_OFF + 2 * 32 * 8 * 4 <= MISC_OFF, "recurrence LDS map");
__device__ __forceinline__ u32x2 scale4(u32x2 w, const f32x4& e) { u32x2 r; r.x = pk2(bf_lo(w.x) * e[0], bf_hi(w.x) * e[1]); r.y = pk2(bf_lo(w.y) * e[2], bf_hi(w.y) * e[3]); return r; }
__device__ __forceinline__ void hg_load(HgRegs& r, const HgCtx& x, int p) {
    const size_t cs = (size_t)p * (32 * 128 * 2);
    const bool has1 = 2 * p + 1 < NCHUNK;
    const size_t c1 = cs + (has1 ? 16 * 128 * 2 : 0), ce = (size_t)p * (2 * 128 * 4), ce1 = ce + (has1 ? 128 * 4 : 0);
    r.q0 = *(const u32x2*)(x.QT + cs + x.toff); r.k0 = *(const u32x2*)(x.KT + cs + x.toff); r.v0 = *(const u32x2*)(x.V + cs + x.toff); r.sg0 = *(const u32x2*)(x.SG + cs + x.toff);
    r.e0 = *(const f32x4*)(x.EB + ce + x.eoff);
    r.q1 = *(const u32x2*)(x.QT + c1 + x.toff); r.k1 = *(const u32x2*)(x.KT + c1 + x.toff); r.v1 = *(const u32x2*)(x.V + c1 + x.toff); r.sg1 = *(const u32x2*)(x.SG + c1 + x.toff);
    r.e1 = *(const f32x4*)(x.EB + ce1 + x.eoff);
}
__device__ __forceinline__ void hg_fix_last(HgRegs& r, int p) {
    if (2 * p + 1 >= NCHUNK) { const u32x2 z = {0u, 0u}; r.q1 = z; r.k1 = z; r.v1 = z; r.e1 = (f32x4){1.f, 1.f, 1.f, 1.f}; }
}
__device__ __forceinline__ void hg_store(const HgRegs& r, const HgCtx& x, LAS unsigned char* lds, int bi) {
    LAS unsigned char* bn = lds + bi * HG_BUF + x.srow * HG_RN + x.sseg * 8;
    LAS unsigned char* bp = lds + bi * HG_BUF + x.srow * HG_RS + (32 * (x.sseg >> 3) + 8 * (x.sseg & 3) + 4 * ((x.sseg >> 2) & 1)) * 2;
    const f32x4 e01 = r.e0 * r.e1;
    *(LAS u32x2*)(bp) = r.q0; *(LAS u32x2*)(bp + HG_TILE) = r.k0; *(LAS u32x2*)(bn + 3 * HG_TILE) = r.v0;
    *(LAS u32x2*)(bp + 4 * HG_TILE) = r.q1; *(LAS u32x2*)(bp + 5 * HG_TILE) = r.k1; *(LAS u32x2*)(bn + 6 * HG_TILE) = scale4(r.k1, r.e1); *(LAS u32x2*)(bn + 7 * HG_TILE) = r.v1;
    *(LAS u32x2*)(bp + 8 * HG_TILE) = scale4(r.q1, r.e0); *(LAS u32x2*)(bn + 9 * HG_TILE) = scale4(r.k0, e01);
    if (x.srow == 0) *(LAS f32x4*)(lds + bi * HG_BUF + 10 * HG_TILE + x.sseg * 16) = e01;
}
__device__ __forceinline__ void hg_frags(bf16x8 (&f)[4], LAS unsigned char* tile, int lv, int g) {
#pragma unroll
    for (int p = 0; p < 4; ++p) f[p] = *(LAS bf16x8*)(tile + lv * HG_RS + (32 * p + 8 * g) * 2);
}
__device__ __forceinline__ f32x4 hg_dot4(const bf16x8 (&a)[4], const bf16x8 (&b)[4]) {
    f32x4 x = {0.f, 0.f, 0.f, 0.f}, y = {0.f, 0.f, 0.f, 0.f};
    x = __builtin_amdgcn_mfma_f32_16x16x32_bf16(a[0], b[0], x, 0, 0, 0); y = __builtin_amdgcn_mfma_f32_16x16x32_bf16(a[1], b[1], y, 0, 0, 0);
    x = __builtin_amdgcn_mfma_f32_16x16x32_bf16(a[2], b[2], x, 0, 0, 0); y = __builtin_amdgcn_mfma_f32_16x16x32_bf16(a[3], b[3], y, 0, 0, 0);
    return x + y;
}
__device__ __forceinline__ void hg_norm_out(const HgCtx& x, LAS unsigned char* lds, int p, u32x2 sg0, u32x2 sg1) {
    const int cb = p & 1;
#pragma unroll
    for (int j = 0; j < 2; ++j) {
        if (j == 1 && 2 * p + 1 >= NCHUNK) break;
        const int trow = 16 * j + x.srow;
        const f32x4 o4 = *(LAS f32x4*)(lds + HG_OB_OFF + cb * HG_OBUF + trow * HG_OROW + x.sseg * 16);
        const f32x4 pa = *(LAS f32x4*)(lds + HG_SQ_OFF + (cb * 32 + trow) * 32), pb = *(LAS f32x4*)(lds + HG_SQ_OFF + (cb * 32 + trow) * 32 + 16);
        const float ss = ((pa[0] + pa[1]) + (pa[2] + pa[3])) + ((pb[0] + pb[1]) + (pb[2] + pb[3]));
        const float rstd = rsqrtf(ss * (1.0f / 128.0f) + EPS);
        const u32x2 sg = j ? sg1 : sg0;
        u32x2 ov; ov.x = pk2(o4[0] * rstd * bf_lo(sg.x), o4[1] * rstd * bf_hi(sg.x)); ov.y = pk2(o4[2] * rstd * bf_lo(sg.y), o4[3] * rstd * bf_hi(sg.y));
        *(u32x2*)(x.A2 + (size_t)(2 * p + j) * (16 * LDK * 2) + x.aoff) = ov;
    }
}
__device__ __forceinline__ void hg_step(f32x4 (&S)[8], HgRegs& RL, HgRegs& RS, u32x2& sgp0, u32x2& sgp1, u32x2& sgc0, u32x2& sgc1, const HgCtx& x, LAS unsigned char* lds, int p) {
    const int cb = p & 1, w = x.w, lv = x.lv, g = x.g;
    hg_load(RL, x, p + 2 < HG_NSTEP ? p + 2 : HG_NSTEP - 1);
    LAS unsigned char* base = lds + cb * HG_BUF;
    bf16x8 sb[4];
#pragma unroll
    for (int q = 0; q < 4; ++q) { u32x4 sw = {pk2(S[2 * q][0], S[2 * q][1]), pk2(S[2 * q][2], S[2 * q][3]), pk2(S[2 * q + 1][0], S[2 * q + 1][1]), pk2(S[2 * q + 1][2], S[2 * q + 1][3])}; sb[q] = __builtin_bit_cast(bf16x8, sw); }
    const s16x4 vb0 = ds_tr16(base + 3 * HG_TILE + (4 * g + (lv >> 2)) * HG_RN + (16 * w + 4 * (lv & 3)) * 2);
    const s16x4 vb1 = ds_tr16(base + 7 * HG_TILE + (4 * g + (lv >> 2)) * HG_RN + (16 * w + 4 * (lv & 3)) * 2);
    const bf16x8 vb01 = {vb0[0], vb0[1], vb0[2], vb0[3], vb1[0], vb1[1], vb1[2], vb1[3]};
    f32x4 O0, O1;
    bf16x8 ka[4]; hg_frags(ka, base + HG_TILE, lv, g);
    {
        bf16x8 qf[4]; hg_frags(qf, base, lv, g);
        f32x4 X = hg_dot4(ka, qf);
        O0 = hg_dot4(qf, sb);
#pragma unroll
        for (int i = 0; i < 4; ++i) X[i] = (4 * g + i <= lv) ? X[i] : 0.f;
        s16x4 xa; { u32x2 wv = {pk2(X[0], X[1]), pk2(X[2], X[3])}; xa = __builtin_bit_cast(s16x4, wv); }
        O0 = __builtin_amdgcn_mfma_f32_16x16x16bf16_1k(xa, vb0, O0, 0, 0, 0);
    }
    {
        bf16x8 qf[4], kf[4], qs[4]; hg_frags(qf, base + 4 * HG_TILE, lv, g); hg_frags(kf, base + 5 * HG_TILE, lv, g); hg_frags(qs, base + 8 * HG_TILE, lv, g);
        f32x4 Xb = hg_dot4(kf, qf); const f32x4 Xa = hg_dot4(ka, qs);
        O1 = hg_dot4(qs, sb);
#pragma unroll
        for (int i = 0; i < 4; ++i) Xb[i] = (4 * g + i <= lv) ? Xb[i] : 0.f;
        u32x4 wv = {pk2(Xa[0], Xa[1]), pk2(Xa[2], Xa[3]), pk2(Xb[0], Xb[1]), pk2(Xb[2], Xb[3])};
        O1 = __builtin_amdgcn_mfma_f32_16x16x32_bf16(__builtin_bit_cast(bf16x8, wv), vb01, O1, 0, 0, 0);
    }
    if (p > 0) hg_norm_out(x, lds, p - 1, sgp0, sgp1);
#pragma unroll
    for (int kt = 0; kt < 8; ++kt) {
        const f32x4 e4 = *(LAS f32x4*)(base + 10 * HG_TILE + (16 * kt + 4 * g) * 4);
        const s16x4 ka = ds_tr16(base + 9 * HG_TILE + (4 * g + (lv >> 2)) * HG_RN + (16 * kt + 4 * (lv & 3)) * 2);
        const s16x4 kb = ds_tr16(base + 6 * HG_TILE + (4 * g + (lv >> 2)) * HG_RN + (16 * kt + 4 * (lv & 3)) * 2);
        const bf16x8 kab = {ka[0], ka[1], ka[2], ka[3], kb[0], kb[1], kb[2], kb[3]};
        S[kt] = S[kt] * e4;
        S[kt] = __builtin_amdgcn_mfma_f32_16x16x32_bf16(kab, vb01, S[kt], 0, 0, 0);
    }
    {   LAS unsigned char* ob = lds + HG_OB_OFF + cb * HG_OBUF + (16 * w + lv) * 4;
#pragma unroll
        for (int i = 0; i < 4; ++i) { *(LAS float*)(ob + (4 * g + i) * HG_OROW) = O0[i]; *(LAS float*)(ob + (16 + 4 * g + i) * HG_OROW) = O1[i]; }
        f32x4 q0 = O0 * O0, q1 = O1 * O1;
#pragma unroll
        for (int i = 0; i < 4; ++i) { q0[i] = row_sum16(q0[i]); q1[i] = row_sum16(q1[i]); }
        if (lv == 0) {
#pragma unroll
            for (int i = 0; i < 4; ++i) { *(LAS float*)(lds + HG_SQ_OFF + ((cb * 32 + 4 * g + i) * 8 + w) * 4) = q0[i]; *(LAS float*)(lds + HG_SQ_OFF + ((cb * 32 + 16 + 4 * g + i) * 8 + w) * 4) = q1[i]; } }
    }
    if (p + 1 < HG_NSTEP) { hg_fix_last(RS, p + 1); hg_store(RS, x, lds, cb ^ 1); }
    const u32x2 sgn0 = RS.sg0, sgn1 = RS.sg1;
    __syncthreads();
    sgp0 = sgc0; sgp1 = sgc1; sgc0 = sgn0; sgc1 = sgn1;
}
__device__ __forceinline__ void hg_prompt_unit(LAS unsigned char* lds, int b, int h, const bf16_t* QT, const bf16_t* KT, const bf16_t* KD, const bf16_t* V, const bf16_t* SG, const float* EBL, bf16_t* A2, float* outS, unsigned* gate = nullptr) {
    HgCtx x;
    x.tid = opaque_tid(); const int lane = x.tid & 63; x.w = __builtin_amdgcn_readfirstlane(x.tid >> 6); x.lv = lane & 15; x.g = lane >> 4; x.srow = x.tid >> 5; x.sseg = x.tid & 31;
    const size_t rowbase = (size_t)b * TP; const int colbase = h * 128;
    {   const size_t ub = (size_t)(b * 32 + h) * TP * 128 * 2;
        x.QT = (const char*)QT + ub; x.KT = (const char*)KT + ub; x.V = (const char*)V + ub; x.SG = (const char*)SG + ub;
        x.A2 = (char*)A2 + (rowbase * LDK + colbase) * 2;
        x.EB = (const char*)EBL + (size_t)(b * 32 + h) * NCHUNK * 128 * 4;
        x.toff = (unsigned)x.tid * 8u; x.eoff = (unsigned)(4 * x.sseg) * 4u; x.aoff = (unsigned)(x.srow * LDK + 4 * x.sseg) * 2u; }
    f32x4 S[8];
#pragma unroll
    for (int i = 0; i < 8; ++i) S[i] = (f32x4){0.f, 0.f, 0.f, 0.f};
    HgRegs R0, R1;
    hg_load(R0, x, 0); hg_store(R0, x, lds, 0); u32x2 sgc0 = R0.sg0, sgc1 = R0.sg1, sgp0 = sgc0, sgp1 = sgc1; hg_load(R1, x, 1);
    __syncthreads();
    for (int p = 0; p < HG_NSTEP; p += 2) {
        if (gate && p == 56) fix_wait_wg(gate, gridDim.x);
        hg_step(S, R0, R1, sgp0, sgp1, sgc0, sgc1, x, lds, p);
        if (p + 1 < HG_NSTEP) hg_step(S, R1, R0, sgp0, sgp1, sgc0, sgc1, x, lds, p + 1);
    }
    hg_norm_out(x, lds, HG_NSTEP - 1, sgp0, sgp1);
    float* so = outS + ((size_t)(b * 32 + h) * 128) * 128 + 16 * x.w + x.lv;
#pragma unroll
    for (int kt = 0; kt < 8; ++kt)
#pragma unroll
        for (int i = 0; i < 4; ++i) so[(size_t)(16 * kt + 4 * x.g + i) * 128] = S[kt][i];
    __syncthreads();
}
__device__ __forceinline__ void hg_sample_unit(LAS unsigned char* lds, int s, int h, const bf16_t* QT, const bf16_t* KT, const bf16_t* KD, const bf16_t* V, const bf16_t* SG, const float* S0, float* S1, bf16_t* A2) {
    const int tid = opaque_tid(), kg = tid >> 5, c4 = tid & 31;
    const size_t ro = ((size_t)BATCH * 32 * TP + (size_t)s * 32 + h) * 128;
    const u32x4 qw = *(const u32x4*)(QT + ro + 8 * kg), kw = *(const u32x4*)(KT + ro + 8 * kg);
    const u32x2 vw = *(const u32x2*)(V + ro + 4 * c4);
    const f32x4 v4 = {bf_lo(vw.x), bf_hi(vw.x), bf_lo(vw.y), bf_hi(vw.y)};
    float qv[8] = {bf_lo(qw.x), bf_hi(qw.x), bf_lo(qw.y), bf_hi(qw.y), bf_lo(qw.z), bf_hi(qw.z), bf_lo(qw.w), bf_hi(qw.w)};
    float kv[8] = {bf_lo(kw.x), bf_hi(kw.x), bf_lo(kw.y), bf_hi(kw.y), bf_lo(kw.z), bf_hi(kw.z), bf_lo(kw.w), bf_hi(kw.w)};
    float fv[8];
#pragma unroll
    for (int i = 0; i < 8; ++i) fv[i] = 1.0f - kv[i];
    const size_t so = (((size_t)s * 32 + h) * 128 + 8 * kg) * 128 + 4 * c4;
    f32x4 oa = {0.f, 0.f, 0.f, 0.f};
    f32x4 s4[8];
#pragma unroll
    for (int i = 0; i < 8; ++i) s4[i] = __builtin_nontemporal_load((const f32x4*)(S0 + so + i * 128));
#pragma unroll
    for (int i = 0; i < 8; ++i) { const f32x4 n4 = s4[i] * fv[i] + v4 * kv[i]; __builtin_nontemporal_store(n4, (f32x4*)(S1 + so + i * 128)); oa += n4 * qv[i]; }
    *(LAS f32x4*)(lds + (kg * 128 + 4 * c4) * 4) = oa;
    __syncthreads();
    if (tid < 32) {
        f32x4 o4 = {0.f, 0.f, 0.f, 0.f};
#pragma unroll
        for (int k = 0; k < 16; ++k) o4 += *(LAS f32x4*)(lds + (k * 128 + 4 * tid) * 4);
        float ss = (o4[0] * o4[0] + o4[1] * o4[1]) + (o4[2] * o4[2] + o4[3] * o4[3]);
#pragma unroll
        for (int o = 1; o < 32; o <<= 1) ss += __shfl_xor(ss, o);
        const float rstd = rsqrtf(ss * (1.0f / 128.0f) + EPS);
        const u32x2 sg = *(const u32x2*)(SG + ro + 4 * tid);
        u32x2 ov; ov.x = pk2(o4[0] * rstd * bf_lo(sg.x), o4[1] * rstd * bf_hi(sg.x)); ov.y = pk2(o4[2] * rstd * bf_lo(sg.y), o4[3] * rstd * bf_hi(sg.y));
        *(u32x2*)(A2 + (size_t)(MPROMPT + s) * LDK + h * 128 + 4 * tid) = ov;
    }
    __syncthreads();
}

__device__ __forceinline__ u32x4 attn_ldblk(const bf16_t* K3, const bf16_t* V3, int b, int n, int tblk, int tid) {
    const int row = tid >> 4, ch = tid & 15, tok = 32 * tblk + row; u32x4 v = {0u, 0u, 0u, 0u};
    if (tok >= 0 && tok < TP) { const size_t o = ((size_t)b * TP + tok) * 512 + n * 64 + (ch & 7) * 8; v = *(const u32x4*)((ch < 8 ? K3 : V3) + o); }
    return v;
}
constexpr int AT_KR = 144, AT_KOFF = 0, AT_VOFF = 6 * 32 * AT_KR, AT_BTOFF = 2 * AT_VOFF, AT_DOFF = AT_BTOFF + 8 * 192 * 4, AT_OOFF = AT_DOFF + 8 * 32 * 4, AT_OROW = 272, AT_OWAVE = 32 * AT_OROW;
static_assert(AT_OOFF + 8 * AT_OWAVE <= MISC_OFF && AT_OOFF % 16 == 0, "attention LDS map");
__device__ __forceinline__ void attn_stblk(LAS unsigned char* lds, u32x4 v, int tblk, int tid) {
    const int row = tid >> 4, ch = tid & 15, slot = (tblk + 8) % 6;
    *(LAS u32x4*)(lds + (ch < 8 ? AT_KOFF : AT_VOFF) + (slot * 32 + row) * AT_KR + (ch & 7) * 16) = v;
}
__device__ __forceinline__ void attn_ldq(bf16x8 (&qf)[4], const bf16_t* Q3, int b, int h, int qb, int q, int hh) {
    const int tq = (32 * qb + q < TP) ? 32 * qb + q : TP - 1; const bf16_t* qp = Q3 + ((size_t)b * TP + tq) * D + h * 64 + 8 * hh;
#pragma unroll
    for (int ds = 0; ds < 4; ++ds) qf[ds] = *(const bf16x8*)(qp + 16 * ds);
}
__device__ __forceinline__ void attn_prompt_run(LAS unsigned char* lds, int b, int n, int qlo, int qhi, const bf16_t* Q3, const bf16_t* K3, const bf16_t* V3, const bf16_t* SG3, const float* BT, const float* sinks, bf16_t* A4) {
    const int tid = opaque_tid(), lane = tid & 63, w = __builtin_amdgcn_readfirstlane(tid >> 6), q = lane & 31, hh = lane >> 5, lv = lane & 15, G = lane >> 4;
    const int h = 8 * n + w;
    {   u32x4 r5[5];
#pragma unroll
        for (int k = 0; k < 5; ++k) r5[k] = attn_ldblk(K3, V3, b, n, qlo - 4 + k, tid);
#pragma unroll
        for (int k = 0; k < 5; ++k) attn_stblk(lds, r5[k], qlo - 4 + k, tid); }
    for (int i = tid; i < 8 * 192; i += 512) { const int x = i / 192, idx = i - x * 192, dist = 159 - idx;
        *(LAS float*)(lds + AT_BTOFF + i * 4) = (dist >= 0 && dist <= WIN) ? BT[(8 * n + x) * 132 + dist] : -1e30f; }
    u32x4 nreg = attn_ldblk(K3, V3, b, n, qlo + 1, tid);
    bf16x8 qn[4]; attn_ldq(qn, Q3, b, h, qlo, q, hh);
    const float sink = sinks[h] * 1.4426950408889634f;
    LAS unsigned char* tbp = lds + AT_BTOFF + (w * 192 + (31 - q) + 4 * hh) * 4;
    LAS unsigned char* ost = lds + AT_OOFF + w * AT_OWAVE;
    __syncthreads();
    for (int i = qlo; i < qhi; ++i) {
        const int t0 = 32 * i;
        if (i + 1 < qhi) attn_stblk(lds, nreg, i + 1, tid);
        if (i + 2 < qhi) nreg = attn_ldblk(K3, V3, b, n, i + 2, tid);
        bf16x8 qf[4];
#pragma unroll
        for (int ds = 0; ds < 4; ++ds) qf[ds] = qn[ds];
        if (i + 1 < qhi) attn_ldq(qn, Q3, b, h, i + 1, q, hh);
        u32x4 sgv[4];
#pragma unroll
        for (int it = 0; it < 4; ++it) { const int tq = t0 + it * 8 + (lane >> 3), tc = tq < TP ? tq : TP - 1; sgv[it] = *(const u32x4*)(SG3 + ((size_t)b * TP + tc) * D + h * 64 + (lane & 7) * 8); }
        int so[5];
#pragma unroll
        for (int kb = 0; kb < 5; ++kb) so[kb] = ((i - 4 + kb + 8) % 6) * 32 * AT_KR;
        f32x16 p[5];
#pragma unroll
        for (int kb = 0; kb < 5; ++kb) {
#pragma unroll
            for (int r = 0; r < 16; ++r) p[kb][r] = *(LAS float*)(tbp + (32 * kb + (r & 3) + 8 * (r >> 2)) * 4);
#pragma unroll
            for (int ds = 0; ds < 4; ++ds) { const bf16x8 kf = *(LAS bf16x8*)(lds + AT_KOFF + so[kb] + q * AT_KR + (16 * ds + 8 * hh) * 2); p[kb] = __builtin_amdgcn_mfma_f32_32x32x16_bf16(kf, qf[ds], p[kb], 0, 0, 0); }
        }
        if (t0 < 128) {
            const int jmin = 128 - t0 - 4 * hh;
#pragma unroll
            for (int kb = 0; kb < 4; ++kb)
#pragma unroll
                for (int r = 0; r < 16; ++r) { const int jc = 32 * kb + (r & 3) + 8 * (r >> 2); p[kb][r] = (jc >= jmin) ? p[kb][r] : -1e30f; }
        }
        float mx = sink;
#pragma unroll
        for (int kb = 0; kb < 5; ++kb)
#pragma unroll
            for (int r = 0; r < 16; r += 2) mx = fmaxf(mx, fmaxf(p[kb][r], p[kb][r + 1]));
        mx = fmaxf(mx, __shfl_xor(mx, 32));
        float sum = 0.f;
        f32x16 o[2];
#pragma unroll
        for (int r = 0; r < 16; ++r) { o[0][r] = 0.f; o[1][r] = 0.f; }
#pragma unroll
        for (int r = 0; r < 16; ++r) { const float e = __builtin_amdgcn_exp2f(p[0][r] - mx); p[0][r] = e; sum += e; }
#pragma unroll
        for (int kb = 0; kb < 5; ++kb) {
#pragma unroll
            for (int ks = 0; ks < 2; ++ks) {
                u32x4 pw = {pk2(p[kb][8 * ks + 0], p[kb][8 * ks + 1]), pk2(p[kb][8 * ks + 2], p[kb][8 * ks + 3]), pk2(p[kb][8 * ks + 4], p[kb][8 * ks + 5]), pk2(p[kb][8 * ks + 6], p[kb][8 * ks + 7])};
                const bf16x8 pa = __builtin_bit_cast(bf16x8, pw);
                const int rowb = 16 * ks + 4 * hh + (lv >> 2);
#pragma unroll
                for (int db = 0; db < 2; ++db) {
                    LAS unsigned char* vp = lds + AT_VOFF + so[kb] + rowb * AT_KR + (32 * db + 16 * (G & 1) + 4 * (lv & 3)) * 2;
                    const s16x4 t0v = ds_tr16(vp), t1v = ds_tr16(vp + 8 * AT_KR);
                    const bf16x8 vb = {t0v[0], t0v[1], t0v[2], t0v[3], t1v[0], t1v[1], t1v[2], t1v[3]};
                    o[db] = __builtin_amdgcn_mfma_f32_32x32x16_bf16(pa, vb, o[db], 0, 0, 0);
                }
            }
            if (kb + 1 < 5) {
#pragma unroll
                for (int r = 0; r < 16; ++r) { const float e = __builtin_amdgcn_exp2f(p[kb + 1][r] - mx); p[kb + 1][r] = e; sum += e; }
#pragma unroll
                for (int i = 0; i < 4; ++i) {
                    __builtin_amdgcn_sched_group_barrier(0x008, 1, 0);
                    __builtin_amdgcn_sched_group_barrier(0x100, 2, 0);
                    __builtin_amdgcn_sched_group_barrier(0x002, 8, 0);
                    __builtin_amdgcn_sched_group_barrier(0x400, 4, 0);
                }
            }
        }
        sum += __shfl_xor(sum, 32);
        const float rden = 1.0f / (sum + __builtin_amdgcn_exp2f(sink - mx));
        if (hh == 0) *(LAS float*)(lds + AT_DOFF + (w * 32 + q) * 4) = rden;
#pragma unroll
        for (int db = 0; db < 2; ++db)
#pragma unroll
            for (int r = 0; r < 16; ++r) *(LAS float*)(ost + ((r & 3) + 8 * (r >> 2) + 4 * hh) * AT_OROW + (32 * db + q) * 4) = o[db][r];
        asm volatile("" : "+v"(sgv[0]), "+v"(sgv[1]), "+v"(sgv[2]), "+v"(sgv[3]));
#pragma unroll
        for (int it = 0; it < 4; ++it) {
            const int row = it * 8 + (lane >> 3), ch = lane & 7, tq = t0 + row;
            const f32x4 a0 = *(LAS f32x4*)(ost + row * AT_OROW + ch * 32), a1 = *(LAS f32x4*)(ost + row * AT_OROW + ch * 32 + 16);
            const float rd = *(LAS float*)(lds + AT_DOFF + (w * 32 + row) * 4);
            if (tq < TP) {
                const u32x4 sg = sgv[it];
                u32x4 ov;
                ov.x = pk2(a0[0] * rd * bf_lo(sg.x), a0[1] * rd * bf_hi(sg.x)); ov.y = pk2(a0[2] * rd * bf_lo(sg.y), a0[3] * rd * bf_hi(sg.y));
                ov.z = pk2(a1[0] * rd * bf_lo(sg.z), a1[1] * rd * bf_hi(sg.z)); ov.w = pk2(a1[2] * rd * bf_lo(sg.w), a1[3] * rd * bf_hi(sg.w));
                *(u32x4*)(A4 + ((size_t)b * TP + tq) * LDK + h * 64 + ch * 8) = ov;
            }
        }
        __syncthreads();
    }
}
__device__ __forceinline__ void attn_sample_unit(LAS unsigned char* lds, int s, int n, const bf16_t* Q3, const bf16_t* K3, const bf16_t* V3, const bf16_t* SG3, const float* BT, const float* sinks,
                                                 const float* ck, const float* cv, float* oks, float* ovs, bf16_t* A4) {
    const int tid = opaque_tid(), lane = tid & 63, w = __builtin_amdgcn_readfirstlane(tid >> 6);
    constexpr int KS = 0, VS = 33792, QS = 67584, PS = 69632;
    LAS float* ksm = (LAS float*)(lds + KS); LAS float* vsm = (LAS float*)(lds + VS); LAS float* qsm = (LAS float*)(lds + QS); LAS float* psm = (LAS float*)(lds + PS);
    const int r = MPROMPT + s, h = 8 * n + w;
    for (int i = tid; i < 128 * 16; i += 512) {
        const int row = i >> 4, c4 = i & 15; const size_t o = (((size_t)s * 128 + row) * 8 + n) * 64 + 4 * c4;
        const f32x4 k4 = *(const f32x4*)(ck + o), v4 = *(const f32x4*)(cv + o);
#pragma unroll
        for (int j = 0; j < 4; ++j) { ksm[row * 65 + 4 * c4 + j] = k4[j]; vsm[row * 65 + 4 * c4 + j] = v4[j]; }
    }
    if (tid < 64) { ksm[128 * 65 + tid] = bf1(K3[(size_t)r * 512 + n * 64 + tid]); vsm[128 * 65 + tid] = bf1(V3[(size_t)r * 512 + n * 64 + tid]); }
    qsm[w * 64 + lane] = bf1(Q3[(size_t)r * D + h * 64 + lane]);
    __syncthreads();
    for (int i = tid; i < 128 * 64; i += 512) { const int rr = i >> 6, d = i & 63; const size_t o = (((size_t)s * 128 + rr) * 8 + n) * 64 + d; oks[o] = ksm[(rr + 1) * 65 + d]; ovs[o] = vsm[(rr + 1) * 65 + d]; }
    float s0 = 0.f, s1 = 0.f, s2 = 0.f;
    for (int d = 0; d < 64; ++d) { const float qd = qsm[w * 64 + d]; s0 += qd * ksm[lane * 65 + d]; s1 += qd * ksm[(lane + 64) * 65 + d]; s2 += qd * ksm[128 * 65 + d]; }
    s0 += BT[h * 132 + (128 - lane)]; s1 += BT[h * 132 + (64 - lane)]; s2 += BT[h * 132];
    float mx = fmaxf(s0, fmaxf(s1, s2));
#pragma unroll
    for (int o = 1; o < 64; o <<= 1) mx = fmaxf(mx, __shfl_xor(mx, o));
    const float sink = sinks[h] * 1.4426950408889634f; mx = fmaxf(mx, sink);
    const float p0 = __builtin_amdgcn_exp2f(s0 - mx), p1 = __builtin_amdgcn_exp2f(s1 - mx), p2 = __builtin_amdgcn_exp2f(s2 - mx);
    float sum = wave_sum(p0 + p1) + p2;
    const float rden = 1.0f / (sum + __builtin_amdgcn_exp2f(sink - mx));
    psm[w * 132 + lane] = p0; psm[w * 132 + 64 + lane] = p1; if (lane == 0) psm[w * 132 + 128] = p2;
    float oa = 0.f;
    for (int j = 0; j < 129; ++j) oa += psm[w * 132 + j] * vsm[j * 65 + lane];
    const size_t go = (size_t)r * D + h * 64 + lane;
    const float outv = oa * rden * bf1(SG3[go]);
    A4[(size_t)r * LDK + h * 64 + lane] = (bf16_t)(pk2(outv, 0.f) & 0xffffu);
    __syncthreads();
}


#define XB_TMO      128
#define XB_XCNT(j)  (256  + 64 * (j))
#define XB_XSUB(j)  (1280 + 64 * (j))
#define XB_XGEN(j)  (2304 + 64 * (j))
#define XB_TOP      3328
#define XB_TOPGEN   3392
#define XCD_BAR_WORDS 3456
#define XB_SPIN_CAP (1u << 20)
__device__ __forceinline__ unsigned xb_ld(unsigned* p)              { return __hip_atomic_load(p, __ATOMIC_RELAXED, __HIP_MEMORY_SCOPE_AGENT); }
__device__ __forceinline__ unsigned xb_add(unsigned* p, unsigned v) { return __hip_atomic_fetch_add(p, v, __ATOMIC_RELAXED, __HIP_MEMORY_SCOPE_AGENT); }
__device__ __forceinline__ unsigned xb_xcc_id() { return (unsigned)__builtin_amdgcn_s_getreg((3 << 11) | 20) & 0xFu; }
#define XB_SPIN(cond, bar) do { unsigned _sp = 0; while (cond) { __builtin_amdgcn_s_sleep(1); \
    if ((++_sp & 255u) == 0u) { if (xb_ld(&(bar)[XB_TMO])) break; if (_sp > XB_SPIN_CAP) { atomicAdd(&(bar)[XB_TMO], 1u); break; } } } } while (0)
struct XcdBarrier { unsigned* bar; unsigned x; volatile LAS unsigned* st; unsigned nloc, nx; };
__device__ __forceinline__ XcdBarrier xcd_barrier_post(unsigned* bar, volatile LAS unsigned* st) {
    XcdBarrier b; b.bar = bar; b.x = xb_xcc_id(); b.st = st; b.nloc = 0u; b.nx = 0u;
    if (threadIdx.x == 0) (void)xb_add(&bar[XB_XCNT(b.x)], 1u);
    return b;
}
__device__ __forceinline__ void xcd_barrier_complete(unsigned* bar, unsigned x, unsigned& nloc, unsigned& nx) {
    const unsigned G = gridDim.x * gridDim.y * gridDim.z;
    unsigned sum, cnt, mine, sp = 0u;
    for (;;) {
        sum = 0u; cnt = 0u; mine = 0u;
#pragma unroll
        for (unsigned j = 0; j < 16; ++j) { const unsigned c = xb_ld(&bar[XB_XCNT(j)]); sum += c; cnt += (c > 0u) ? 1u : 0u; mine = (j == x) ? c : mine; }
        if (sum == G) break;
        __builtin_amdgcn_s_sleep(1);
        if ((++sp & 255u) == 0u) { if (xb_ld(&bar[XB_TMO])) break; if (sp > XB_SPIN_CAP) { atomicAdd(&bar[XB_TMO], 1u); break; } }
    }
    nloc = mine > 0u ? mine : 1u; nx = cnt > 0u ? cnt : 1u;
}
__device__ __forceinline__ void xcd_barrier(XcdBarrier& b) {
    asm volatile("s_waitcnt vmcnt(0)" ::: "memory");
    __syncthreads();
    if (threadIdx.x == 0) {
        unsigned* bar = b.bar;
        __builtin_amdgcn_s_waitcnt(0);
        unsigned nloc = b.nloc, nx = b.nx;
        if (nloc == 0u) { xcd_barrier_complete(bar, b.x, nloc, nx); b.st[0] = nloc; b.st[1] = nx; }
        const unsigned old = xb_add(&bar[XB_XSUB(b.x)], 1u);
        const unsigned gen = old / nloc;
        if (old + 1u == (gen + 1u) * nloc) {
            __builtin_amdgcn_fence(__ATOMIC_RELEASE, "agent");
            asm volatile("s_waitcnt vmcnt(0)" ::: "memory");
            const unsigned og = xb_add(&bar[XB_TOP], 1u);
            const unsigned tg = og / nx;
            if (og + 1u == (tg + 1u) * nx) xb_add(&bar[XB_TOPGEN], 1u);
            else XB_SPIN(xb_ld(&bar[XB_TOPGEN]) == tg, bar);
            __builtin_amdgcn_fence(__ATOMIC_ACQUIRE, "agent");
            xb_add(&bar[XB_XGEN(b.x)], 1u);
            asm volatile("s_waitcnt vmcnt(0)" ::: "memory");
        } else {
            XB_SPIN(xb_ld(&bar[XB_XGEN(b.x)]) == gen, bar);
            __builtin_amdgcn_fence(__ATOMIC_ACQUIRE, "agent");
            asm volatile("s_waitcnt vmcnt(0)" ::: "memory");
        }
    }
    __syncthreads();
    if (b.nloc == 0u) { b.nloc = __builtin_amdgcn_readfirstlane(b.st[0]); b.nx = __builtin_amdgcn_readfirstlane(b.st[1]); }
}

struct UnitSync { XcdBarrier b; __device__ __forceinline__ void sync() const { XcdBarrier t = b; xcd_barrier(t); } };
#ifndef USYNC3
#define USYNC3 0
#endif
__global__ void __launch_bounds__(512, 2) hgswa_fwd(Args args) {
    extern __shared__ __attribute__((aligned(16))) unsigned char lds_raw[];
    LAS unsigned char* lds = (LAS unsigned char*)lds_raw;
    const int G = gridDim.x, c = blockIdx.x;
    unsigned char* ws = args.ws;
    const int lo = args.ph_lo, hi = args.ph_hi, sub = args.sub;
    float* SLAB = (float*)(ws + WS_SLAB);
    XcdBarrier xbar; xbar.bar = (unsigned*)(ws + WS_CTL); xbar.x = 0; xbar.st = (volatile LAS unsigned*)(lds + MISC_OFF); xbar.nloc = 0u; xbar.nx = 0u;
    if (args.sync) {
        if (threadIdx.x < 2) ((volatile LAS unsigned*)(lds + MISC_OFF))[threadIdx.x] = 0u;
        __syncthreads();
        xbar = xcd_barrier_post((unsigned*)(ws + WS_CTL), (volatile LAS unsigned*)(lds + MISC_OFF));
    }
    UnitSync usn; usn.b = xbar;
#define IN(k) (lo <= (k) && (k) < hi)
#define GRIDBAR() xcd_barrier(xbar)
#define SEAM(k) do { if (IN(k) && IN((k) + 1)) { GRIDBAR(); } } while (0)
    bf16_t* B0 = (bf16_t*)(ws + WS_B0); bf16_t* B1 = (bf16_t*)(ws + WS_B0 + BUFB); bf16_t* B2 = (bf16_t*)(ws + WS_B0 + 2 * BUFB); bf16_t* B3 = (bf16_t*)(ws + WS_B0 + 3 * BUFB);
    bf16_t* B4 = (bf16_t*)(ws + WS_B0 + 4 * BUFB); bf16_t* B5 = (bf16_t*)(ws + WS_B0 + 5 * BUFB);
    float* X1 = (float*)(ws + WS_X1); float* EBL = (float*)(ws + WS_EBL);
    bf16_t* K3 = (bf16_t*)(ws + WS_K3); bf16_t* V3 = (bf16_t*)(ws + WS_V3);
    unsigned long long* SSQ1 = (unsigned long long*)(ws + WS_SSQ1); unsigned long long* SSQ2 = (unsigned long long*)(ws + WS_SSQ2);
    const float* BT = (const float*)(ws + WS_BT);
    unsigned* const ctl = (unsigned*)(ws + WS_CTL);
    const bool relax = (G == 256) && args.sync && PROBE_PHASE < 0 && lo == 0 && hi >= 8;

    for (int rep_ = 0; rep_ < (PROBE_PHASE == 0 ? 2 : 1); ++rep_) { if (rep_) GRIDBAR();
    if (IN(0)) { p0_prep(args, G, lds); }
        }
    SEAM(0);
    for (int rep_ = 0; rep_ < (PROBE_PHASE == 1 ? 2 : 1); ++rep_) { if (rep_) GRIDBAR();
    if (IN(1)) {
        pg8::Gemm g{B0, (const bf16_t*)(ws + WS_W1), MP, N1, D, LDK}; pg8::TailOrder<4, 0, 0> S; S.init(MFULL, N1, G, c);
        EpiHg E{B1, B2, B3, B4, B5, EBL, (const float*)(ws + WS_RSTD0), (const float*)(ws + WS_LB)};
        if (sub != 2) pg8::gemm_phase<EpiHg, pg8::TailOrder<4, 0, 0>, PGALIGN, PGSP2, UnitSync>(lds, g, S, E, SLAB, usn, false, 0);
        if (sub == 0) GRIDBAR();
        if (sub != 1) { pg8::gemm_tail_fixup<4, EpiHg>(SLAB, N1 / 256, MFULL / 256, G, c, E, relax ? 128 : 0, relax ? 128 : 0); fix_done(ctl, 0); }
    }
        }
    if (!relax) SEAM(1);
    for (int rep_ = 0; rep_ < ((PROBE_PHASE == 2 || PROBE_PHASE == 12 || PROBE_PHASE == 13) ? 2 : 1); ++rep_) { if (rep_) GRIDBAR();
    if (IN(2)) {
        if (G == 256) {
            if (c < 128) { if (!(rep_ == 1 && PROBE_PHASE == 13)) hg_prompt_unit(lds, c >> 5, c & 31, B1, B2, B3, B4, B5, EBL, B3, args.out + O_SP, (relax && (c >> 5) == BATCH - 1) ? ctl + XB_FIX(0) : nullptr); }
            else if (!(rep_ == 1 && PROBE_PHASE == 12)) {
                if (!relax) for (int u = c - 128; u < NS * 32; u += 128) hg_sample_unit(lds, u >> 5, u & 31, B1, B2, B3, B4, B5, args.in[I_STATE], args.out + O_SS, B3);
                const int tid = opaque_tid(), wv = tid >> 6, ln = tid & 63; constexpr int CR = WC2 + WC3; LAS unsigned char* scr = lds + wv * WSCR;
                w_convert1(args, (c - 128) * 8 + wv, CR * 64, 1024, CR, WC1, ln, scr);
                if (relax) { __syncthreads(); fix_wait_wg(ctl + XB_FIX(0), G);
                    for (int u = c - 128; u < NS * 32; u += 128) hg_sample_unit(lds, u >> 5, u & 31, B1, B2, B3, B4, B5, args.in[I_STATE], args.out + O_SS, B3); }
            }
        } else {
            for (int u = c; u < 128 + NS * 32; u += G) {
                if (u < 128) hg_prompt_unit(lds, u >> 5, u & 31, B1, B2, B3, B4, B5, EBL, B3, args.out + O_SP);
                else hg_sample_unit(lds, (u - 128) >> 5, (u - 128) & 31, B1, B2, B3, B4, B5, args.in[I_STATE], args.out + O_SS, B3);
            }
        }
    }
        }
    SEAM(2);
    for (int rep_ = 0; rep_ < (PROBE_PHASE == 3 ? 2 : 1); ++rep_) { if (rep_) GRIDBAR();
    if (IN(3)) {
        pg8::Gemm g{B3, (const bf16_t*)(ws + WS_W2), MP, N2, D, LDK}; pg8::TailOrder<16, 0, 0> S; S.init(MFULL, N2, G, c);
        EpiRes E{B0, B1, SSQ1};
        if (PROBE_PHASE == 3 && rep_ == 0) { E.XO = (bf16_t*)(ws + WS_X1); E.SSQ = (unsigned long long*)(ws + WS_X1 + (size_t)96 * 1024 * 1024); }
        if (sub != 2) pg8::gemm_phase<EpiRes, pg8::TailOrder<16, 0, 0>, PGALIGN, PGSP2, UnitSync>(lds, g, S, E, SLAB, usn, false, 0);
        if (sub == 0) GRIDBAR();
        if (sub != 1) { pg8::gemm_tail_fixup<16, EpiRes>(SLAB, N2 / 256, MFULL / 256, G, c, E, relax ? 164 : 0, relax ? 92 : 0); fix_done(ctl, 1); }
    }
        }
    if (!relax) SEAM(3);
    for (int rep_ = 0; rep_ < ((PROBE_PHASE == 4 || (PROBE_PHASE >= 400 && PROBE_PHASE <= 405)) ? 2 : 1); ++rep_) { if (rep_) GRIDBAR();
    if (IN(4)) {
        pg8::Gemm g{B1, (const bf16_t*)(ws + WS_W3), MP, N3, D, LDK, relax ? ctl + XB_FIX(1) : nullptr, MFULL / 256, MV}; pg8::StaticOrder S; S.init(MP, N3, G, c);
        EpiSw E{B2, K3, V3, B3, SSQ1};
        if (rep_ == 0 || PROBE_PHASE == 4) pg8::gemm_phase<EpiSw, pg8::StaticOrder, PGALIGN, PGSP2, UnitSync>(lds, g, S, E, nullptr, usn, (USYNC3 && args.sync), (MP / 256 * (N3 / 256) + G - 1) / G);
        else { EpiDummy ED{SLAB}; constexpr int AB = (PROBE_PHASE >= 400 && PROBE_PHASE <= 405) ? PROBE_PHASE - 400 : 0;
            pg8::gemm_phase<EpiDummy, pg8::StaticOrder, true, PGSP2, UnitSync, AB>(lds, g, S, ED, nullptr, usn, false, 0); }
        if (G == 256 && rep_ == 0) {
            constexpr int NU3 = (MP / 256) * (N3 / 256), NFULL = NU3 % 256, NIDLE = 256 - NFULL;
            if (c >= NFULL) { const int tid = opaque_tid(); w_convert(args, (c - NFULL) * 8 + (tid >> 6), WC4 * 64, NIDLE * 8, WC4, WC1 + WC2 + WC3, tid & 63, lds + (tid >> 6) * WSCR); }
        }
    }
        }
    SEAM(4);
    for (int rep_ = 0; rep_ < ((PROBE_PHASE == 5 || PROBE_PHASE == 51 || PROBE_PHASE == 52) ? 2 : 1); ++rep_) { if (rep_) GRIDBAR();
    if (IN(5)) {
        if (!(rep_ == 1 && PROBE_PHASE > 5)) {   float* okp = args.out + O_KP; float* ovp = args.out + O_VP; const int tid = opaque_tid();
            for (int i = c * 512 + tid; i < BATCH * 128 * 512; i += G * 512) { const int b = i >> 16, rr = (i >> 9) & 127, cc = i & 511; const size_t o = ((size_t)b * TP + (TP - 128) + rr) * 512 + cc; okp[i] = bf1(K3[o]); ovp[i] = bf1(V3[o]); } }
        constexpr int NQB = (TP + 31) / 32;
        if (!(rep_ == 1 && PROBE_PHASE == 52)) {   const int GR = G >= 32 ? G / 32 : 1;
            for (int grp = c / GR; grp < BATCH * 8; grp += (G + GR - 1) / GR) {
                const int jr = c % GR, qlo = (NQB * jr) / GR, qhi = (NQB * (jr + 1)) / GR;
                attn_prompt_run(lds, grp >> 3, grp & 7, qlo, qhi, B2, K3, V3, B3, BT, args.in[I_SWSINK], B4);
            }
        }
        if (!(rep_ == 1 && PROBE_PHASE == 51)) for (int v = c; v < NS * 8; v += G) attn_sample_unit(lds, v >> 3, v & 7, B2, K3, V3, B3, BT, args.in[I_SWSINK], args.in[I_CK], args.in[I_CV], args.out + O_KS, args.out + O_VS, B4);
    }
        }
    SEAM(5);
    if (IN(6)) {
        pg8::Gemm g{B4, (const bf16_t*)(ws + WS_W4), MP, N4, D, LDK}; pg8::TailOrder<16, 0, 0> S; S.init(MFULL, N4, G, c);
        EpiRes E{B1, B1, SSQ2};
        if (sub != 2) pg8::gemm_phase<EpiRes, pg8::TailOrder<16, 0, 0>, PGALIGN, PGSP2, UnitSync>(lds, g, S, E, SLAB, usn, false, 0);
        if (sub == 0) GRIDBAR();
        if (sub != 1) { pg8::gemm_tail_fixup<16, EpiRes>(SLAB, N4 / 256, MFULL / 256, G, c, E, relax ? 64 : 0, relax ? 64 : 0); fix_done(ctl, 2); }
    }
    if (!relax) SEAM(6);
    for (int rep_ = 0; rep_ < (PROBE_PHASE == 7 ? 2 : 1); ++rep_) { if (rep_) GRIDBAR();
    if (IN(7)) {
        const int tid = opaque_tid(), lane = tid & 63, gw = c * 8 + (tid >> 6), NGW = G * 8; const float* fn = args.in[I_FNORM];
        bool p7gated = false;
        for (int r = gw; r < MV; r += NGW) {
            if (relax && r >= MFULL && !p7gated) { fix_wait_wave(ctl + XB_FIX(2), G); p7gated = true; }
            float* dst;
            if (r < MPROMPT) { const int b = r / TP, t = r - b * TP; if (t < NMETA) continue; dst = args.out + O_YP + ((size_t)b * SEQ + (t - NMETA)) * D; }
            else dst = args.out + O_YS + (size_t)(r - MPROMPT) * D;
            const float rs = rstd_from_ssq(SSQ2[r]); const bf16_t* src = B1 + (size_t)r * LDK;
#pragma unroll
            for (int j = 0; j < 8; ++j) { const int o = j * 512 + lane * 8; const u32x4 xw = *(const u32x4*)(src + o); const f32x4 g0 = *(const f32x4*)(fn + o), g1 = *(const f32x4*)(fn + o + 4);
                const f32x4 x0 = {bf_lo(xw.x), bf_hi(xw.x), bf_lo(xw.y), bf_hi(xw.y)}, x1 = {bf_lo(xw.z), bf_hi(xw.z), bf_lo(xw.w), bf_hi(xw.w)};
                __builtin_nontemporal_store(x0 * rs * g0, (f32x4*)(dst + o)); __builtin_nontemporal_store(x1 * rs * g1, (f32x4*)(dst + o + 4)); }
        }
    }
    }
    #undef IN
#undef SEAM
#undef GRIDBAR
}

extern "C" void kernel_launch(void* const* d_in, const int* in_sizes, int n_in, void* d_out, int out_size, void* d_ws, size_t ws_size, hipStream_t stream) {
    static int grid = 0;
    if (grid == 0) {
        if (n_in != 17 || (size_t)out_size != O_END || ws_size < WS_END) { fprintf(stderr, "kernel_launch: unexpected shapes (n_in %d, out %d, ws %zu)\n", n_in, out_size, ws_size); grid = -1; return; }
        int dev = 0, cus = 0, per_cu = 0;
        if (hipGetDevice(&dev) != hipSuccess || hipDeviceGetAttribute(&cus, hipDeviceAttributeMultiprocessorCount, dev) != hipSuccess) { grid = -1; return; }
        if (hipFuncSetAttribute((const void*)hgswa_fwd, hipFuncAttributeMaxDynamicSharedMemorySize, LDS_BYTES) != hipSuccess) { fprintf(stderr, "kernel_launch: hipFuncSetAttribute failed\n"); grid = -1; return; }
        if (hipOccupancyMaxActiveBlocksPerMultiprocessor(&per_cu, (const void*)hgswa_fwd, 512, LDS_BYTES) != hipSuccess || per_cu < 1) { fprintf(stderr, "kernel_launch: occupancy query says %d blocks per CU\n", per_cu); grid = -1; (void)hipGetLastError(); return; }
        grid = cus;
    }
    if (grid < 0) return;
    (void)hipMemsetAsync((char*)d_ws + WS_CTL, 0, CTL_ZERO_BYTES, stream);
    Args a{};
    for (int i = 0; i < 17; ++i) a.in[i] = (const float*)d_in[i];
    a.out = (float*)d_out; a.ws = (unsigned char*)d_ws;
#if MK_N_LAUNCHES == 1
    a.ph_lo = 0; a.ph_hi = 8; a.sync = 1;
    void* kargs[] = {&a};
    hipError_t e = hipLaunchCooperativeKernel((const void*)hgswa_fwd, dim3(grid), dim3(512), kargs, LDS_BYTES, stream);
    if (e != hipSuccess) fprintf(stderr, "kernel_launch: cooperative launch failed: %s\n", hipGetErrorString(e));
#else
    for (int p = 0; p < 8; ++p) { a.ph_lo = p; a.ph_hi = p + 1; a.sync = 0;
        if (p == 1 || p == 3 || p == 6) { a.sub = 1; hipLaunchKernelGGL(hgswa_fwd, dim3(grid), dim3(512), LDS_BYTES, stream, a); a.sub = 2; hipLaunchKernelGGL(hgswa_fwd, dim3(grid), dim3(512), LDS_BYTES, stream, a); a.sub = 0; }
        else hipLaunchKernelGGL(hgswa_fwd, dim3(grid), dim3(512), LDS_BYTES, stream, a); }
#endif
}
```
